# Optimizing an MI355X kernel written in HIP

```python
import math
import jax, jax.numpy as jnp
from jax import lax
import numpy as np

D_MODEL = 2048
BATCH = 2
SEQ = 4096
DEPTH = 2

N_BRANCH = 4
BRANCH_WIDTH = 512
HEAD_DIM = 64
ATT_BLOCK = 128
ROPE_THETA = 500000.0
ROPE_DIM = HEAD_DIM // 4
NORM_EPS = 1e-6
GLA_HEADS = 4
GLA_DK = 64
GLA_DV = BRANCH_WIDTH // GLA_HEADS
GLA_LOWRANK = 16
GLA_TAU = 16.0
GLA_CHUNK = 64
GLA_SUB = 16
S5_WIDTH = BRANCH_WIDTH
S5_GROUP = 16
S5_GROUPS = S5_WIDTH // S5_GROUP
S5_STATE = 64
S5_DT_MIN = 0.001
S5_DT_MAX = 0.1
DIL_HEADS = BRANCH_WIDTH // HEAD_DIM
DIL_CONFIGS = ((128, 1), (512, 4), (2048, 16))
DIL_MAX_DILATION = 16
SWA_HEADS = BRANCH_WIDTH // HEAD_DIM
SWA_KV_HEADS = 2
SWA_WINDOW = 128
FFN_MULTIPLE = 256
FFN_HIDDEN = -((-8 * D_MODEL) // (3 * FFN_MULTIPLE)) * FFN_MULTIPLE
IN_SPLITS = (GLA_HEADS * GLA_DK, GLA_HEADS * GLA_DK, GLA_HEADS * GLA_DV, GLA_HEADS * GLA_DV, GLA_LOWRANK,
             S5_WIDTH,
             DIL_HEADS * HEAD_DIM, DIL_HEADS * HEAD_DIM, DIL_HEADS * HEAD_DIM,
             SWA_HEADS * HEAD_DIM, SWA_KV_HEADS * HEAD_DIM, SWA_KV_HEADS * HEAD_DIM,
             N_BRANCH * D_MODEL)
D_IN = sum(IN_SPLITS)

kernel_name = 'hybrid_gla_s5_dilated_swa_block'


def rms_norm(x, g):
    xf = x.astype(jnp.float32)
    y = xf * lax.rsqrt(jnp.mean(xf * xf, axis=-1, keepdims=True) + NORM_EPS)
    return (y * g.astype(jnp.float32)).astype(x.dtype)


def rotary_partial(x, positions):
    half = ROPE_DIM // 2
    inv_freq = ROPE_THETA ** (-jnp.arange(half, dtype=jnp.float32) / half)
    ang = positions.astype(jnp.float32)[:, :, None] * inv_freq
    cos, sin = jnp.cos(ang)[:, :, None, :], jnp.sin(ang)[:, :, None, :]
    xr = x[..., :ROPE_DIM].astype(jnp.float32)
    x1, x2 = xr[..., :half], xr[..., half:]
    rot = jnp.concatenate([x1 * cos - x2 * sin, x2 * cos + x1 * sin], axis=-1)
    return jnp.concatenate([rot.astype(x.dtype), x[..., ROPE_DIM:]], axis=-1)


def banded_attention(q, k, v, max_dist):
    f = jnp.float32
    b, l, hq, hd = q.shape
    hkv = k.shape[2]
    grp = hq // hkv
    t = ATT_BLOCK
    nb = l // t
    qb = q.astype(f).reshape(b, nb, t, hkv, grp, hd)

    def with_prev(z):
        z = z.astype(f).reshape(b, nb, t, hkv, hd)
        prev = jnp.concatenate([jnp.zeros_like(z[:, :1]), z[:, :-1]], axis=1)
        return jnp.concatenate([prev, z], axis=2)

    kk, vv = with_prev(k), with_prev(v)
    s = jnp.einsum('bnqhgd,bnkhd->bnhgqk', qb, kk) * (hd ** -0.5)
    qi = jnp.arange(t)[:, None]
    kj = jnp.arange(2 * t)[None, :]
    dist = t + qi - kj
    blk = jnp.arange(nb)[:, None, None]
    valid = (dist >= 0) & (dist <= max_dist) & (blk * t + kj - t >= 0)
    s = jnp.where(valid[None, :, None, None], s, -jnp.inf)
    m = jnp.max(s, axis=-1, keepdims=True)
    p = jnp.exp(s - m)
    den = jnp.sum(p, axis=-1)
    o = jnp.einsum('bnhgqk,bnkhd->bnqhgd', p, vv) / den.transpose(0, 1, 4, 2, 3)[..., None]
    lse = (m[..., 0] + jnp.log(den)).transpose(0, 1, 4, 2, 3)
    return o.reshape(b, l, hq, hd).astype(q.dtype), lse.reshape(b, l, hq)


def to_strided(z, dil):
    b, lp, h, hd = z.shape
    return z.reshape(b, lp // dil, dil, h, hd).transpose(0, 2, 1, 3, 4).reshape(b * dil, lp // dil, h, hd)


def from_strided(z, b, dil):
    bd, ls = z.shape[:2]
    rest = z.shape[2:]
    z = z.reshape((b, dil, ls) + rest)
    z = jnp.swapaxes(z, 1, 2)
    return z.reshape((b, ls * dil) + rest)


def dilated_attention(q, k, v):
    f = jnp.float32
    b, l, h, hd = q.shape
    span = ATT_BLOCK * DIL_MAX_DILATION
    lp = -(-l // span) * span
    pad = ((0, 0), (0, lp - l), (0, 0), (0, 0))
    q, k, v = jnp.pad(q, pad), jnp.pad(k, pad), jnp.pad(v, pad)
    outs, lses = [], []
    for window, dil in DIL_CONFIGS:
        o, lse = banded_attention(to_strided(q, dil), to_strided(k, dil), to_strided(v, dil), window // dil)
        outs.append(from_strided(o, b, dil)[:, :l].astype(f))
        lses.append(from_strided(lse, b, dil)[:, :l])
    wts = jax.nn.softmax(jnp.stack(lses, axis=0), axis=0)
    return jnp.einsum('cblh,cblhd->blhd', wts, jnp.stack(outs, axis=0))


def gla_chunked(q, k, v, log_a):
    f = jnp.float32
    b, l, h, dk = q.shape
    dv = v.shape[-1]
    c = GLA_CHUNK
    n = l // c
    ns = c // GLA_SUB
    t = GLA_SUB

    def chunks(z):
        return z.astype(f).reshape(b, n, c, h, z.shape[-1]).transpose(0, 3, 1, 2, 4)

    q, k, v, g = chunks(q), chunks(k), chunks(v), chunks(log_a)
    q = q * (dk ** -0.5)
    cum = jnp.cumsum(g, axis=3)
    qs = q.reshape(b, h, n, ns, t, dk)
    ks = k.reshape(b, h, n, ns, t, dk)
    cs = cum.reshape(b, h, n, ns, t, dk)
    ref = cs[:, :, :, :, 0] - g.reshape(b, h, n, ns, t, dk)[:, :, :, :, 0]
    q_ref = qs * jnp.exp(cs - ref[:, :, :, :, None])
    earlier = (jnp.arange(c) // t)[None, :] < jnp.arange(ns)[:, None]
    k_ref = k[:, :, :, None] * jnp.exp(jnp.where(earlier[:, :, None], ref[:, :, :, :, None] - cum[:, :, :, None], -jnp.inf))
    a_off = jnp.einsum('bhnstk,bhnsjk->bhnstj', q_ref, k_ref)
    tri = jnp.arange(t)[:, None] >= jnp.arange(t)[None, :]
    dec = jnp.exp(jnp.where(tri[:, :, None], cs[..., :, None, :] - cs[..., None, :, :], -jnp.inf))
    a_diag = jnp.einsum('bhnstk,bhnsuk,bhnstuk->bhnstu', qs, ks, dec)
    a = a_off + (a_diag[:, :, :, :, :, None, :] * jnp.eye(ns, dtype=f)[:, None, :, None]).reshape(b, h, n, ns, t, c)
    o_intra = jnp.einsum('bhnstj,bhnjv->bhnstv', a, v).reshape(b, h, n, c, dv)
    last = cum[:, :, :, -1]
    kv = jnp.einsum('bhnck,bhncv->nbhkv', k * jnp.exp(last[:, :, :, None] - cum), v)

    def step(state, inp):
        decay, upd = inp
        return state * decay[..., None] + upd, state

    _, states = lax.scan(step, jnp.zeros((b, h, dk, dv), f), (jnp.exp(last).transpose(2, 0, 1, 3), kv))
    o_inter = jnp.einsum('bhnck,nbhkv->bhncv', q * jnp.exp(cum), states)
    return (o_intra + o_inter).transpose(0, 2, 3, 1, 4).reshape(b, l, h, dv)


def s5_mixer(u, lam_re, lam_im, log_dt, b_re, b_im, c_re, c_im, d, glu_w, glu_b):
    f = jnp.float32
    bsz, l, _ = u.shape
    uf = u.astype(f).reshape(bsz, l, S5_GROUPS, S5_GROUP)
    dt = jnp.exp(log_dt.astype(f))[:, None]
    lr, li = lam_re.astype(f), lam_im.astype(f)
    mag = jnp.exp(lr * dt)
    ab_re, ab_im = mag * jnp.cos(li * dt), mag * jnp.sin(li * dt)
    den = lr * lr + li * li
    z_re = ((ab_re - 1.0) * lr + ab_im * li) / den
    z_im = (ab_im * lr - (ab_re - 1.0) * li) / den
    br, bi = b_re.astype(f), b_im.astype(f)
    bb_re = z_re[..., None] * br - z_im[..., None] * bi
    bb_im = z_re[..., None] * bi + z_im[..., None] * br
    x_re = jnp.einsum('gnc,blgc->blgn', bb_re, uf)
    x_im = jnp.einsum('gnc,blgc->blgn', bb_im, uf)
    a_re = jnp.broadcast_to(ab_re, x_re.shape)
    a_im = jnp.broadcast_to(ab_im, x_im.shape)

    def combine(e1, e2):
        a1r, a1i, b1r, b1i = e1
        a2r, a2i, b2r, b2i = e2
        return (a1r * a2r - a1i * a2i, a1r * a2i + a1i * a2r,
                a2r * b1r - a2i * b1i + b2r, a2r * b1i + a2i * b1r + b2i)

    _, _, h_re, h_im = lax.associative_scan(combine, (a_re, a_im, x_re, x_im), axis=1)
    y = (jnp.einsum('gcn,blgn->blgc', c_re.astype(f), h_re)
         - jnp.einsum('gcn,blgn->blgc', c_im.astype(f), h_im)
         + d.astype(f) * uf).reshape(bsz, l, S5_WIDTH)
    z = jax.nn.gelu(y)
    return z * jax.nn.sigmoid(z @ glu_w.astype(f) + glu_b.astype(f))


def hybrid_mixer(h, positions, w_in, gla_a2, gla_a_b, gla_norm_g, s5_lambda_re, s5_lambda_im, s5_log_dt,
                 s5_b_re, s5_b_im, s5_c_re, s5_c_im, s5_d, s5_glu_w, s5_glu_b, swa_sinks, w_branch, w_out):
    f = jnp.float32
    b, l, _ = h.shape
    proj = h @ w_in
    points = np.cumsum(IN_SPLITS)[:-1].tolist()
    (gq, gk, gv, gr, glr, s5u, cq, ck, cv, sq, sk, sv, gates) = jnp.split(proj, points, axis=-1)

    def heads(z, nh):
        return z.reshape(b, l, nh, -1)

    log_a = jax.nn.log_sigmoid((glr @ gla_a2 + gla_a_b).astype(f)) / GLA_TAU
    o = gla_chunked(heads(gq, GLA_HEADS), heads(gk, GLA_HEADS), heads(gv, GLA_HEADS), heads(log_a, GLA_HEADS))
    o_gla = rms_norm(o, gla_norm_g) * jax.nn.silu(heads(gr, GLA_HEADS).astype(f))
    o_s5 = s5_mixer(s5u, s5_lambda_re, s5_lambda_im, s5_log_dt, s5_b_re, s5_b_im, s5_c_re, s5_c_im,
                    s5_d, s5_glu_w, s5_glu_b)
    o_dil = dilated_attention(rotary_partial(heads(cq, DIL_HEADS), positions),
                              rotary_partial(heads(ck, DIL_HEADS), positions), heads(cv, DIL_HEADS))
    o, lse = banded_attention(rotary_partial(heads(sq, SWA_HEADS), positions),
                              rotary_partial(heads(sk, SWA_KV_HEADS), positions),
                              heads(sv, SWA_KV_HEADS), SWA_WINDOW - 1)
    o_swa = o.astype(f) * jax.nn.sigmoid(lse - swa_sinks.astype(f))[..., None]
    branch_outs = (o_gla, o_s5, o_dil, o_swa)
    gate = jax.nn.sigmoid(gates.reshape(b, l, N_BRANCH, D_MODEL))
    mixed = sum(gate[:, :, m] * (br.reshape(b, l, BRANCH_WIDTH).astype(h.dtype) @ w_branch[m])
                for m, br in enumerate(branch_outs))
    return mixed @ w_out


def swiglu(h, w_gate, w_up, w_down):
    return (jax.nn.silu(h @ w_gate) * (h @ w_up)) @ w_down


def setup_inputs(seed: int = 0) -> dict:
    key = jax.random.key(seed)
    ks = jax.random.split(key, 26)
    f = jnp.float32

    def nrm(k, shape, scale):
        return scale * jax.random.normal(k, shape, f)

    def gain(k, shape):
        return 1.0 + 0.02 * jax.random.normal(k, shape, f)

    n_idx = jnp.arange(S5_STATE, dtype=f)
    gshape = (DEPTH, S5_GROUPS, S5_STATE)
    return {
        'x': jax.random.normal(ks[0], (BATCH, SEQ, D_MODEL), f),
        'positions': jnp.arange(SEQ, dtype=jnp.int32)[None, :] + jax.random.randint(ks[1], (BATCH, 1), 0, 1024, dtype=jnp.int32),
        'norm1_g': gain(ks[2], (DEPTH, D_MODEL)),
        'w_in': nrm(ks[3], (DEPTH, D_MODEL, D_IN), D_MODEL ** -0.5),
        'gla_a2': nrm(ks[4], (DEPTH, GLA_LOWRANK, GLA_HEADS * GLA_DK), GLA_LOWRANK ** -0.5),
        'gla_a_b': nrm(ks[5], (DEPTH, GLA_HEADS * GLA_DK), 0.1),
        'gla_norm_g': gain(ks[6], (DEPTH, GLA_HEADS, GLA_DV)),
        's5_lambda_re': -0.5 + nrm(ks[7], gshape, 0.01),
        's5_lambda_im': math.pi * n_idx + nrm(ks[8], gshape, 0.01),
        's5_log_dt': jax.random.uniform(ks[9], (DEPTH, S5_GROUPS), f, math.log(S5_DT_MIN), math.log(S5_DT_MAX)),
        's5_b_re': nrm(ks[10], (DEPTH, S5_GROUPS, S5_STATE, S5_GROUP), (2 * S5_GROUP) ** -0.5),
        's5_b_im': nrm(ks[11], (DEPTH, S5_GROUPS, S5_STATE, S5_GROUP), (2 * S5_GROUP) ** -0.5),
        's5_c_re': nrm(ks[12], (DEPTH, S5_GROUPS, S5_GROUP, S5_STATE), S5_STATE ** -0.5),
        's5_c_im': nrm(ks[13], (DEPTH, S5_GROUPS, S5_GROUP, S5_STATE), S5_STATE ** -0.5),
        's5_d': nrm(ks[14], (DEPTH, S5_GROUPS, S5_GROUP), 1.0),
        's5_glu_w': nrm(ks[15], (DEPTH, S5_WIDTH, S5_WIDTH), S5_WIDTH ** -0.5),
        's5_glu_b': nrm(ks[16], (DEPTH, S5_WIDTH), 0.01),
        'swa_sinks': nrm(ks[17], (DEPTH, SWA_HEADS), 1.0),
        'w_branch': nrm(ks[18], (DEPTH, N_BRANCH, BRANCH_WIDTH, D_MODEL), BRANCH_WIDTH ** -0.5),
        'w_out': nrm(ks[19], (DEPTH, D_MODEL, D_MODEL), D_MODEL ** -0.5),
        'norm2_g': gain(ks[20], (DEPTH, D_MODEL)),
        'w_ffn_gate': nrm(ks[21], (DEPTH, D_MODEL, FFN_HIDDEN), D_MODEL ** -0.5),
        'w_ffn_up': nrm(ks[22], (DEPTH, D_MODEL, FFN_HIDDEN), D_MODEL ** -0.5),
        'w_ffn_down': nrm(ks[23], (DEPTH, FFN_HIDDEN, D_MODEL), FFN_HIDDEN ** -0.5),
        'final_norm_g': gain(ks[24], (D_MODEL,)),
    }


def reference(x, positions, norm1_g, w_in, gla_a2, gla_a_b, gla_norm_g, s5_lambda_re, s5_lambda_im, s5_log_dt,
              s5_b_re, s5_b_im, s5_c_re, s5_c_im, s5_d, s5_glu_w, s5_glu_b, swa_sinks, w_branch, w_out,
              norm2_g, w_ffn_gate, w_ffn_up, w_ffn_down, final_norm_g):
    for i in range(DEPTH):
        h = rms_norm(x, norm1_g[i])
        x = x + hybrid_mixer(h, positions, w_in[i], gla_a2[i], gla_a_b[i], gla_norm_g[i], s5_lambda_re[i],
                             s5_lambda_im[i], s5_log_dt[i], s5_b_re[i], s5_b_im[i], s5_c_re[i], s5_c_im[i],
                             s5_d[i], s5_glu_w[i], s5_glu_b[i], swa_sinks[i], w_branch[i], w_out[i])
        h = rms_norm(x, norm2_g[i])
        x = x + swiglu(h, w_ffn_gate[i], w_ffn_up[i], w_ffn_down[i])
    return rms_norm(x, final_norm_g)
```

```cpp
#include <hip/hip_runtime.h>
#include <hip/hip_cooperative_groups.h>
#include <cstdio>
#include <cstdint>
namespace cg = cooperative_groups;
#ifndef REP_PRO
#define REP_PRO 1
#endif
#ifndef REP_MIX
#define REP_MIX 1
#endif
#ifndef REP_G17
#define REP_G17 1
#endif
#ifndef REP_P2
#define REP_P2 1
#endif
#ifndef REP_P3
#define REP_P3 1
#endif
#ifndef REP_P4
#define REP_P4 1
#endif
#ifndef REP_S3
#define REP_S3 1
#endif
#ifndef REP_G3
#define REP_G3 1
#endif
#ifndef REP_G1
#define REP_G1 1
#endif
#ifndef REP_G5
#define REP_G5 1
#endif
#ifndef IN1_EARLY
#define IN1_EARLY 1800
#endif
#ifndef REP_SYNC
#define REP_SYNC 1
#endif
#define GSYNC() do { for (int rs_ = 0; rs_ < REP_SYNC; ++rs_) xcd_barrier(xbar); } while (0)

namespace pg8 {
#define PG8_LAS __attribute__((address_space(3)))
typedef unsigned short bf16_t;
typedef short bf16x8 __attribute__((ext_vector_type(8)));
typedef float f32x4 __attribute__((ext_vector_type(4)));
typedef unsigned u32x4 __attribute__((ext_vector_type(4)));
typedef unsigned u32x2 __attribute__((ext_vector_type(2)));
constexpr int BM = 256, BK = 64, HALF = 128, HTB = HALF * BK * 2, STAGE_BYTES = 8 * HTB, NXCD = 8, WGM = 2;

__host__ __device__ __forceinline__ int lds_byte(int r, int c) { const int st = (r >> 4) * 2 + (c >> 5), rr = r & 15, cc = c & 31, ob = rr * 64 + cc * 2; return st * 1024 + (ob ^ (((ob >> 9) & 1) << 5)); }
__host__ __device__ __forceinline__ void stage_rc(int b, int& R, int& C) { const int st = b / 1024, sb = b % 1024, swz = sb ^ (((sb >> 9) & 1) << 5); R = (st >> 1) * 16 + swz / 64; C = (st & 1) * 32 + (swz % 64) / 2; }
__host__ __device__ __forceinline__ int perm32(int rho) { const int n = rho >> 4, i = rho & 15; return 8 * (i >> 2) + 4 * n + (i & 3); }

struct Unit { int pm, pn, kz; };
struct Gemm { const bf16_t* A; const bf16_t* Bt; int lda, ldb, K; };

struct StaticOrder {
    int nM, nN, nwg, G, c;
    __host__ __device__ void init(int M, int N, int G_, int c_) { nM = M / BM; nN = N / BM; nwg = nM * nN; G = G_; c = c_; }
    __host__ __device__ bool next(int i, Unit& u) const {
        const long L = (long)i * G + c; if (L >= nwg) return false;
        int wgid = (int)L; { const int q = nwg / NXCD, r = nwg % NXCD, xcd = wgid % NXCD, off = wgid / NXCD; wgid = (xcd < r ? xcd * (q + 1) : r * (q + 1) + (xcd - r) * q) + off; }
        const int nig = WGM * nN, gid = wgid / nig, fm = gid * WGM, gsz = (nM - fm) < WGM ? (nM - fm) : WGM;
        u.pm = fm + ((wgid % nig) % gsz); u.pn = (wgid % nig) / gsz; u.kz = 0; return true;
    }
};
struct BranchOrder {
    int G, c;
    __host__ __device__ bool next(int i, Unit& u) const {
        const int tile = c + (i >> 2) * G; if (tile >= 256) return false;
        const int x = tile & 7, idx = tile >> 3;
        u.pm = 4 * x + (idx >> 3); u.pn = idx & 7; u.kz = i & 3; return true;
    }
};

__device__ __forceinline__ unsigned cvt_pk_bf16(float lo, float hi) { unsigned r; asm volatile("v_cvt_pk_bf16_f32 %0, %1, %2" : "=v"(r) : "v"(lo), "v"(hi)); return r; }
__device__ __forceinline__ float fsigmoid(float x) { return __frcp_rn(1.0f + __expf(-x)); }

struct EpiInProj {
    static constexpr bool PERM = true, CHAIN = false;
    float* projm; bf16_t* gates; bf16_t* abf; const float* rope; const float* ssq;
    __device__ __forceinline__ void operator()(f32x4 (&acc)[2][2][4][2], const Unit& u, int wr, int wc, int fr, int fq) const {
        const int row0 = u.pm * BM + wr * 64 + fr; const int colt = u.pn * BM; const int cw = wc * 32 + 8 * fq;
        const bool attn_tile = (colt >= 2048) && (colt < 4352);
        float rstd[2][4];
#pragma unroll
        for (int ai = 0; ai < 2; ++ai)
#pragma unroll
            for (int m = 0; m < 4; ++m) rstd[ai][m] = ssq[row0 + ai * HALF + m * 16];
#pragma unroll
        for (int ai = 0; ai < 2; ++ai)
#pragma unroll
            for (int m = 0; m < 4; ++m) rstd[ai][m] = rsqrtf(rstd[ai][m] * (1.0f / 2048.0f) + 1e-6f);
        if (attn_tile) {
            const bool rotw = (wc & 1) == 0;
#pragma unroll
            for (int aim = 0; aim < 4; ++aim) { const int ai = aim >> 1, mb = (aim & 1) * 2;
                f32x4 rp[4][4];
                if (rotw) {
#pragma unroll
                    for (int m = mb; m < mb + 2; ++m) { const float* rr = rope + (size_t)(row0 + ai * HALF + m * 16) * 16;
#pragma unroll
                        for (int q = 0; q < 4; ++q) rp[m][q] = *(const f32x4*)(rr + 4 * q); }
                }
#pragma unroll
                for (int m = mb; m < mb + 2; ++m) {
                    const int row = row0 + ai * HALF + m * 16;
#pragma unroll
                    for (int bj = 0; bj < 2; ++bj) {
                        f32x4 v0 = acc[ai][bj][m][0] * rstd[ai][m], v1 = acc[ai][bj][m][1] * rstd[ai][m];
                        const int cb = colt + bj * HALF;
                        const bool isrot = (cb < 3072) || (cb >= 3584 && cb < 4224);
                        const bool isq = (cb < 2560) || (cb >= 3584 && cb < 4096);
                        if (isrot && rotw) {
#pragma unroll
                            for (int j = 0; j < 4; ++j) { const float p0 = __shfl_xor(v0[j], 16), p1 = __shfl_xor(v1[j], 16);
                                if (fq == 0) { v0[j] = v0[j] * rp[m][0][j] - p0 * rp[m][2][j]; v1[j] = v1[j] * rp[m][1][j] - p1 * rp[m][3][j]; }
                                else if (fq == 1) { v0[j] = v0[j] * rp[m][0][j] + p0 * rp[m][2][j]; v1[j] = v1[j] * rp[m][1][j] + p1 * rp[m][3][j]; } }
                        }
                        if (isq) { v0 = v0 * 0.125f; v1 = v1 * 0.125f; }
                        u32x4 w; w.x = cvt_pk_bf16(v0[0], v0[1]); w.y = cvt_pk_bf16(v0[2], v0[3]); w.z = cvt_pk_bf16(v1[0], v1[1]); w.w = cvt_pk_bf16(v1[2], v1[3]);
                        __builtin_nontemporal_store(w, (u32x4*)(abf + (size_t)row * 2304 + (cb + cw - 2048)));
                    }
                }
            }
            return;
        }
#pragma unroll
        for (int ai = 0; ai < 2; ++ai)
#pragma unroll
            for (int m = 0; m < 4; ++m) {
                const int row = row0 + ai * HALF + m * 16;
#pragma unroll
                for (int bj = 0; bj < 2; ++bj) {
                    f32x4 v0 = acc[ai][bj][m][0] * rstd[ai][m], v1 = acc[ai][bj][m][1] * rstd[ai][m];
                    const int col = colt + bj * HALF + cw;
                    if (colt < 4608) {
                        float* p = projm + (size_t)row * 4608 + col;
                        __builtin_nontemporal_store(v0, (f32x4*)p); __builtin_nontemporal_store(v1, (f32x4*)(p + 4));
                    } else {
                        u32x4 w; w.x = cvt_pk_bf16(fsigmoid(v0[0]), fsigmoid(v0[1])); w.y = cvt_pk_bf16(fsigmoid(v0[2]), fsigmoid(v0[3]));
                        w.z = cvt_pk_bf16(fsigmoid(v1[0]), fsigmoid(v1[1])); w.w = cvt_pk_bf16(fsigmoid(v1[2]), fsigmoid(v1[3]));
                        __builtin_nontemporal_store(w, (u32x4*)(gates + (size_t)row * 8192 + (col - 4608)));
                    }
                }
            }
    }
};
__device__ __forceinline__ float bf_lo(unsigned w) { return __uint_as_float(w << 16); }
__device__ __forceinline__ float bf_hi(unsigned w) { return __uint_as_float(w & 0xffff0000u); }
struct EpiBranch {
    static constexpr bool PERM = true, CHAIN = true;
    const bf16_t* gates; bf16_t* mixb;
    __device__ __forceinline__ void operator()(f32x4 (&acc)[2][2][4][2], const Unit& u, int wr, int wc, int fr, int fq) const {
        const int row0 = u.pm * BM + wr * 64 + fr; const int col0 = u.pn * BM + wc * 32 + 8 * fq;
#pragma unroll
        for (int aim = 0; aim < 4; ++aim) { const int ai = aim >> 1, mb = (aim & 1) * 2;
            u32x4 g[4][2], hn[4][2];
#pragma unroll
            for (int m = mb; m < mb + 2; ++m)
#pragma unroll
                for (int bj = 0; bj < 2; ++bj) { const bf16_t* gp = gates + (size_t)(row0 + ai * HALF + m * 16) * 8192 + u.kz * 2048 + col0 + bj * HALF;
                    g[m][bj] = *(const u32x4*)gp; hn[m][bj] = (u.kz < 3) ? *(const u32x4*)(gp + 2048) : (u32x4){0u, 0u, 0u, 0u}; }
#pragma unroll
            for (int m = mb; m < mb + 2; ++m) {
                const int row = row0 + ai * HALF + m * 16;
#pragma unroll
                for (int bj = 0; bj < 2; ++bj) {
                    const int col = col0 + bj * HALF;
                    const u32x4 gg = g[m][bj], h = hn[m][bj];
                    float sc[8] = {bf_lo(gg.x), bf_hi(gg.x), bf_lo(gg.y), bf_hi(gg.y), bf_lo(gg.z), bf_hi(gg.z), bf_lo(gg.w), bf_hi(gg.w)};
                    if (u.kz < 3) {
                        const float dn[8] = {bf_lo(h.x), bf_hi(h.x), bf_lo(h.y), bf_hi(h.y), bf_lo(h.z), bf_hi(h.z), bf_lo(h.w), bf_hi(h.w)};
#pragma unroll
                        for (int j = 0; j < 8; ++j) sc[j] *= __frcp_rn(fmaxf(dn[j], 1e-30f)); }
                    f32x4 v0 = acc[ai][bj][m][0], v1 = acc[ai][bj][m][1];
#pragma unroll
                    for (int j = 0; j < 4; ++j) { v0[j] *= sc[j]; v1[j] *= sc[4 + j]; }
                    acc[ai][bj][m][0] = v0; acc[ai][bj][m][1] = v1;
                    if (u.kz == 3) { u32x4 w; w.x = cvt_pk_bf16(v0[0], v0[1]); w.y = cvt_pk_bf16(v0[2], v0[3]); w.z = cvt_pk_bf16(v1[0], v1[1]); w.w = cvt_pk_bf16(v1[2], v1[3]);
                        *(u32x4*)(mixb + (size_t)row * 2048 + col) = w; }
                }
            }
        }
    }
};
struct EpiResid {
    static constexpr bool PERM = true, CHAIN = false;
    const float* resid; float* out; bf16_t* xb; float* ssq;
    __device__ __forceinline__ void operator()(f32x4 (&acc)[2][2][4][2], const Unit& u, int wr, int wc, int fr, int fq) const {
        const int row0 = u.pm * BM + wr * 64 + fr; const int col0 = u.pn * BM + wc * 32 + 8 * fq;
#pragma unroll
        for (int aim = 0; aim < 2; ++aim) { const int ai = aim, mb = 0;
            f32x4 rv[4][2][2];
#pragma unroll
            for (int m = mb; m < mb + 4; ++m)
#pragma unroll
                for (int bj = 0; bj < 2; ++bj) { const float* rp = resid + (size_t)(row0 + ai * HALF + m * 16) * 2048 + col0 + bj * HALF; rv[m][bj][0] = *(const f32x4*)rp; rv[m][bj][1] = *(const f32x4*)(rp + 4); }
#pragma unroll
            for (int m = mb; m < mb + 4; ++m) {
                const int row = row0 + ai * HALF + m * 16; float s = 0.f;
#pragma unroll
                for (int bj = 0; bj < 2; ++bj) {
                    const size_t off = (size_t)row * 2048 + col0 + bj * HALF;
                    const f32x4 v0 = rv[m][bj][0] + acc[ai][bj][m][0], v1 = rv[m][bj][1] + acc[ai][bj][m][1];
                    *(f32x4*)(out + off) = v0; *(f32x4*)(out + off + 4) = v1;
                    u32x4 w; w.x = cvt_pk_bf16(v0[0], v0[1]); w.y = cvt_pk_bf16(v0[2], v0[3]); w.z = cvt_pk_bf16(v1[0], v1[1]); w.w = cvt_pk_bf16(v1[2], v1[3]);
                    *(u32x4*)(xb + off) = w;
                    s += (v0[0] * v0[0] + v0[1] * v0[1]) + (v0[2] * v0[2] + v0[3] * v0[3]) + (v1[0] * v1[0] + v1[1] * v1[1]) + (v1[2] * v1[2] + v1[3] * v1[3]);
                }
                s += __shfl_xor(s, 16); s += __shfl_xor(s, 32);
                if (fq == 0) atomicAdd(ssq + row, s);
            }
        }
    }
};
struct EpiGateUp {
    static constexpr bool PERM = true, CHAIN = false;
    bf16_t* hid; const float* ssq;
    __device__ __forceinline__ void operator()(f32x4 (&acc)[2][2][4][2], const Unit& u, int wr, int wc, int fr, int fq) const {
        const int row0 = u.pm * BM + wr * 64 + fr; const int col0 = u.pn * HALF + wc * 32 + 8 * fq;
        float rs[2][4];
#pragma unroll
        for (int ai = 0; ai < 2; ++ai)
#pragma unroll
            for (int m = 0; m < 4; ++m) rs[ai][m] = ssq[row0 + ai * HALF + m * 16];
#pragma unroll
        for (int ai = 0; ai < 2; ++ai)
#pragma unroll
            for (int m = 0; m < 4; ++m) {
                const int row = row0 + ai * HALF + m * 16;
                const float rstd = rsqrtf(rs[ai][m] * (1.0f / 2048.0f) + 1e-6f);
                float o[8];
#pragma unroll
                for (int n = 0; n < 2; ++n)
#pragma unroll
                    for (int j = 0; j < 4; ++j) { const float g = acc[ai][0][m][n][j] * rstd, up = acc[ai][1][m][n][j] * rstd; o[n * 4 + j] = g * fsigmoid(g) * up; }
                u32x4 w; w.x = cvt_pk_bf16(o[0], o[1]); w.y = cvt_pk_bf16(o[2], o[3]); w.z = cvt_pk_bf16(o[4], o[5]); w.w = cvt_pk_bf16(o[6], o[7]);
                __builtin_nontemporal_store(w, (u32x4*)(hid + (size_t)row * 5632 + col0));
            }
    }
};

template <class Epi, class Sched>
__device__ __forceinline__ void gemm_phase(PG8_LAS unsigned char* lds, const Gemm g, const Sched& S, const Epi& E) {
    int tid_ = threadIdx.x; asm volatile("" : "+v"(tid_));
    const int tid = tid_, wid = __builtin_amdgcn_readfirstlane(tid >> 6), lane = tid & 63, wr = wid >> 2, wc = wid & 3, fr = lane & 15, fq = lane >> 4;
    const int K = g.K, nt = K / BK;
    unsigned voffA[2], voffB[2];
#pragma unroll
    for (int i = 0; i < 2; ++i) { int R, C; stage_rc(tid * 16 + i * 8192, R, C); const int Rb = Epi::PERM ? ((R & ~31) + perm32(R & 31)) : R;
        voffA[i] = (unsigned)(R * g.lda + C) * 2u; voffB[i] = (unsigned)(Rb * g.ldb + C) * 2u; }
    const size_t kstep = (size_t)(BK * 2);
    const size_t hstepA = (size_t)HALF * g.lda * 2, hstepB = (size_t)HALF * g.ldb * 2;
    const size_t tstepA = 2 * hstepA, tstepB = 2 * hstepB;
    const unsigned ldsw = (unsigned)wid * 1024u;
    const int aoff = lds_byte(wr * 64 + fr, fq * 8), boff = lds_byte(wc * 32 + fr, fq * 8);
#define PG8_SA(b, h) (((b) * 2 + (h)) * HTB)
#define PG8_SB(b, h) ((4 + (b) * 2 + (h)) * HTB)
#define PG8_STAGE(bufoff, gbase, voff) do { _Pragma("unroll") for (int _i = 0; _i < 2; ++_i) \
        __builtin_amdgcn_global_load_lds((const unsigned*)((const char*)(gbase) + (voff)[_i]), (PG8_LAS unsigned*)(lds + (bufoff) + ldsw + _i * 8192), 16, 0, 0); } while (0)
#define PG8_LDA(dst, b, h) do { _Pragma("unroll") for (int m = 0; m < 4; ++m) _Pragma("unroll") for (int k = 0; k < 2; ++k) dst[m][k] = *(const PG8_LAS bf16x8*)(lds + PG8_SA(b, h) + aoff + m * 2048 + k * 1024); } while (0)
#define PG8_LDB(dst, b, h) do { _Pragma("unroll") for (int n = 0; n < 2; ++n) _Pragma("unroll") for (int k = 0; k < 2; ++k) dst[n][k] = *(const PG8_LAS bf16x8*)(lds + PG8_SB(b, h) + boff + n * 2048 + k * 1024); } while (0)
#define PG8_MMA(ai, bj, At, Bt) do { __builtin_amdgcn_s_setprio(1); _Pragma("unroll") for (int m = 0; m < 4; ++m) _Pragma("unroll") for (int n = 0; n < 2; ++n) _Pragma("unroll") for (int k = 0; k < 2; ++k) \
        acc[ai][bj][m][n] = __builtin_amdgcn_mfma_f32_16x16x32_bf16(Bt[n][k], At[m][k], acc[ai][bj][m][n], 0, 0, 0); __builtin_amdgcn_s_setprio(0); } while (0)
#define PG8_WAIT_V(n) asm volatile("s_waitcnt vmcnt(" #n ")" ::: "memory")
#define PG8_WAIT_L(n) asm volatile("s_waitcnt lgkmcnt(" #n ")" ::: "memory")
#define PG8_BAR __builtin_amdgcn_s_barrier()
#define PG8_SCHED __builtin_amdgcn_sched_barrier(0)
    Unit cur, nxt; int ui = 0;
    if (!S.next(0, cur)) return;
    f32x4 acc[2][2][4][2];
#pragma unroll
    for (int a = 0; a < 2; ++a)
#pragma unroll
        for (int b = 0; b < 2; ++b)
#pragma unroll
            for (int m = 0; m < 4; ++m)
#pragma unroll
                for (int n = 0; n < 2; ++n) acc[a][b][m][n] = (f32x4){0.f, 0.f, 0.f, 0.f};
    bf16x8 At[4][2], B0[2][2], B1[2][2];
    const char* cA = (const char*)g.A + (size_t)cur.pm * tstepA + (size_t)cur.kz * K * 2; const char* cB = (const char*)g.Bt + (size_t)cur.pn * tstepB + (size_t)cur.kz * K * 2;
    PG8_STAGE(PG8_SB(0, 0), cB, voffB); PG8_STAGE(PG8_SB(0, 1), cB + hstepB, voffB); PG8_STAGE(PG8_SA(0, 0), cA, voffA); PG8_STAGE(PG8_SA(0, 1), cA + hstepA, voffA);
    if (wr == 1) PG8_BAR;
    PG8_WAIT_V(2); PG8_BAR;
    PG8_STAGE(PG8_SB(1, 0), cB + kstep, voffB); PG8_STAGE(PG8_SA(1, 0), cA + kstep, voffA); PG8_STAGE(PG8_SB(1, 1), cB + hstepB + kstep, voffB);
    PG8_WAIT_V(6); PG8_BAR;
    for (;;) {
        const bool has_next = S.next(ui + 1, nxt);
        const char* nA = has_next ? (const char*)g.A + (size_t)nxt.pm * tstepA + (size_t)nxt.kz * K * 2 : cA;
        const char* nB = has_next ? (const char*)g.Bt + (size_t)nxt.pn * tstepB + (size_t)nxt.kz * K * 2 : cB;
        for (int t = 0; t < nt; t += 2) {
            const bool last = (t == nt - 2);
            const char* a1 = cA + (size_t)(t + 1) * kstep;
            const char* a2 = last ? nA : cA + (size_t)(t + 2) * kstep; const char* b2 = last ? nB : cB + (size_t)(t + 2) * kstep;
            const char* a3 = a2 + kstep; const char* b3 = b2 + kstep;
            PG8_LDB(B0, 0, 0); PG8_LDB(B1, 0, 1); PG8_SCHED; PG8_LDA(At, 0, 0); PG8_STAGE(PG8_SA(1, 1), a1 + hstepA, voffA);
            PG8_WAIT_V(8); PG8_WAIT_L(0); PG8_BAR; PG8_MMA(0, 0, At, B0); PG8_MMA(0, 1, At, B1); PG8_BAR; PG8_SCHED;
            PG8_LDA(At, 0, 1); PG8_STAGE(PG8_SB(0, 0), b2, voffB); PG8_STAGE(PG8_SB(0, 1), b2 + hstepB, voffB); PG8_STAGE(PG8_SA(0, 0), a2, voffA);
            PG8_WAIT_V(8); PG8_WAIT_L(0); PG8_BAR; PG8_MMA(1, 0, At, B0); PG8_MMA(1, 1, At, B1); PG8_BAR; PG8_SCHED;
            PG8_LDB(B0, 1, 0); PG8_LDB(B1, 1, 1); PG8_SCHED; PG8_LDA(At, 1, 0); PG8_STAGE(PG8_SA(0, 1), a2 + hstepA, voffA);
            PG8_WAIT_V(8); PG8_WAIT_L(0); PG8_BAR; PG8_MMA(0, 0, At, B0); PG8_MMA(0, 1, At, B1); PG8_BAR; PG8_SCHED;
            PG8_LDA(At, 1, 1); PG8_STAGE(PG8_SB(1, 0), b3, voffB); PG8_STAGE(PG8_SB(1, 1), b3 + hstepB, voffB); PG8_STAGE(PG8_SA(1, 0), a3, voffA);
            PG8_WAIT_V(8); PG8_WAIT_L(0); PG8_BAR; PG8_MMA(1, 0, At, B0); PG8_MMA(1, 1, At, B1); PG8_BAR; PG8_SCHED;
        }
        if (wr == 0) PG8_BAR;
        E(acc, cur, wr, wc, fr, fq);
        if (!has_next) break;
        if (!(Epi::CHAIN && nxt.kz != 0)) {
#pragma unroll
        for (int a = 0; a < 2; ++a)
#pragma unroll
            for (int b = 0; b < 2; ++b)
#pragma unroll
                for (int m = 0; m < 4; ++m)
#pragma unroll
                    for (int n = 0; n < 2; ++n) acc[a][b][m][n] = (f32x4){0.f, 0.f, 0.f, 0.f};
        }
        cur = nxt; cA = nA; cB = nB; ++ui;
        if (wr == 1) PG8_BAR;
    }
    PG8_WAIT_V(0);
    PG8_BAR;
#undef PG8_SA
#undef PG8_SB
#undef PG8_STAGE
#undef PG8_LDA
#undef PG8_LDB
#undef PG8_MMA
#undef PG8_WAIT_V
#undef PG8_WAIT_L
#undef PG8_BAR
#undef PG8_SCHED
}
}

typedef unsigned short bf16;
typedef float f32x4 __attribute__((ext_vector_type(4)));
typedef short bf16x8 __attribute__((ext_vector_type(8)));
typedef short s16x4 __attribute__((ext_vector_type(4)));
typedef unsigned v4u __attribute__((ext_vector_type(4)));
typedef unsigned v2u __attribute__((ext_vector_type(2)));
constexpr int NWAVES = 8, NTHR = 512;
constexpr int SEQ = 4096, M = 8192, D = 2048, DIN = 12560, NMIX = 4608, NIN = 12800, FF = 5632, NGU = 11264;
constexpr int C_GQ = 0, C_GK = 256, C_GV = 512, C_GR = 1024, C_S5 = 1536, C_CQ = 2048, C_CK = 2560, C_CV = 3072, C_SQ = 3584, C_SK = 4096, C_SV = 4224, C_LR = 4352;
__host__ __device__ __forceinline__ int orig_col(int c) { return c < 1536 ? c : c < 4352 ? c + 16 : c < 4368 ? c - 4352 + 1536 : c < 4608 ? -1 : c - 240; }

constexpr size_t MiB = 1u << 20;
constexpr size_t WS_SSQ = 0, WS_CNT = 512 * 1024, WS_BAR = 768 * 1024, WS_S5A = 1536 * 1024, WS_S5B = 1600 * 1024, WS_ROPE = 1 * MiB, WS_GLAST = 2 * MiB, WS_GLU = 3 * MiB, WS_WT = 4 * MiB, WT_LAYER = 132 * MiB;
constexpr size_t WT_IN = 0, WT_BR = 50 * MiB, WT_OUT = 58 * MiB, WT_GU = 66 * MiB, WT_DN = 110 * MiB;
constexpr size_t WS_XB = 268 * MiB, WS_PROJM = 300 * MiB, WS_MIXF = 300 * MiB, WS_MIXB = 364 * MiB, WS_GATES = 444 * MiB, WS_HID = 444 * MiB, WS_BR = 572 * MiB;
constexpr size_t WS_GKV = 604 * MiB, WS_GST = 620 * MiB, WS_S5E = 636 * MiB, WS_S5C = 640 * MiB, WS_OPART = 644 * MiB, WS_ML = 692 * MiB, WS_ABF = 694 * MiB, WS_GCUM = 730 * MiB, WS_END = 738 * MiB;
constexpr int LDS_BYTES = 147456;
#define XCD_BAR_WORDS 3456

struct Args { const float* in[25]; float* out; unsigned char* ws; };

__device__ __forceinline__ unsigned f2bf(float f) { unsigned u = __float_as_uint(f); return (u + 0x7fffu + ((u >> 16) & 1u)) >> 16; }
__device__ __forceinline__ unsigned pk2(float lo, float hi) { return f2bf(lo) | (f2bf(hi) << 16); }
__device__ __forceinline__ float wave_sum(float v) {
#pragma unroll
    for (int o = 1; o < 64; o <<= 1) v += __shfl_xor(v, o);
    return v;
}
#define LDS_WAIT() asm volatile("s_waitcnt lgkmcnt(0)" ::: "memory")
__device__ __forceinline__ int launder_v(int x) { asm volatile("" : "+v"(x)); return x; }
template <class T> __device__ __forceinline__ T* launder_p(T* p) { asm volatile("" : "+s"(p)); return p; }

template <int MODE>
__device__ __forceinline__ void transpose_item(const float* w0, const float* w1, int ld_src, const float* scale, bf16* dst, int ld_dst, int koff, int nblk, float* scr, int item, int lane) {
    const int kb = item / nblk, nb = item % nblk, k0 = 64 * kb, n0 = 64 * nb;
    const int n_ = n0 + lane;
    const float* cp;
    if (MODE == 0) cp = w0 + n_;
    else if (MODE == 1) { const int oc = orig_col(n_); cp = w0 + (oc >= 0 ? oc : 0); }
    else cp = ((n_ & 255) < 128 ? w0 : w1) + (n_ >> 8) * 128 + (n_ & 127);
    const bool valid = (MODE != 1) || (orig_col(n_) >= 0);
    cp += (size_t)k0 * ld_src;
    float tv[64];
#pragma unroll
    for (int kk = 0; kk < 64; ++kk) tv[kk] = cp[(size_t)kk * ld_src];
#pragma unroll
    for (int kk = 0; kk < 64; ++kk) { float v = tv[kk]; if (!valid) v = 0.f; if (scale) v *= scale[k0 + kk]; scr[kk * 65 + lane] = v; }
    LDS_WAIT(); asm volatile("" ::: "memory");
    const int c = lane & 7;
#pragma unroll
    for (int j = 0; j < 8; ++j) { const int n = (lane >> 3) + 8 * j; const float* sp = scr + (8 * c) * 65 + n;
        v4u o; o.x = pk2(sp[0 * 65], sp[1 * 65]); o.y = pk2(sp[2 * 65], sp[3 * 65]); o.z = pk2(sp[4 * 65], sp[5 * 65]); o.w = pk2(sp[6 * 65], sp[7 * 65]);
        *(v4u*)(dst + (size_t)(n0 + n) * ld_dst + koff + k0 + 8 * c) = o; }
    LDS_WAIT(); asm volatile("" ::: "memory");
}

__device__ __forceinline__ void prologue(const Args& a, unsigned char* lds, int tid, int lane, int wave, int G) {
    unsigned char* ws = a.ws;
    const int gw = blockIdx.x * NWAVES + wave, NGW = G * NWAVES;
    const int gtid = blockIdx.x * NTHR + tid, NGT = G * NTHR;
    float* ssq = (float*)(ws + WS_SSQ);
    for (int i = gtid; i < 4 * M; i += NGT) ssq[M + i] = 0.f;
    if (gtid < 64) ((unsigned*)(ws + WS_CNT))[gtid] = 0u;
    if (gtid < XCD_BAR_WORDS) ((unsigned*)(ws + WS_BAR))[gtid] = 0u;
    { const int* pos = (const int*)a.in[1]; float* rope = (float*)(ws + WS_ROPE);
      for (int i = gtid; i < M * 8; i += NGT) { const int tok = i >> 3, f = i & 7;
          const double invf = f == 0 ? 1.0 : f == 1 ? 0.19392274474868576 : f == 2 ? 0.03760603093086393 : f == 3 ? 0.007292664737217109 : f == 4 ? 0.001414213562373095 : f == 5 ? 0.0002742481756762073 : f == 6 ? 5.318295896944988e-05 : 1.031338537721246e-05;
          const double ang = (double)pos[tok] * invf; const double kq = rint(ang * 0.15915494309189535); const float rr = (float)(ang - kq * 6.283185307179586);
          rope[tok * 16 + f] = cosf(rr); rope[tok * 16 + 8 + f] = sinf(rr); } }
    if (gtid < 4096) { const int n = gtid & 63, g = (gtid >> 6) & 31, l = gtid >> 11;
        const float dt = expf(a.in[9][l * 32 + g]);
        const float lr = a.in[7][(l * 32 + g) * 64 + n], li = a.in[8][(l * 32 + g) * 64 + n];
        const float mag = expf(lr * dt); const float ar = mag * cosf(li * dt), ai = mag * sinf(li * dt);
        float pr = ar, pi = ai;
#pragma unroll
        for (int i = 0; i < 5; ++i) { const float nr = pr * pr - pi * pi, ni = 2.0f * pr * pi; pr = nr; pi = ni; }
        *(f32x4*)((float*)(ws + WS_S5A) + (size_t)gtid * 4) = (f32x4){ar, ai, pr, pi};
        const float den = lr * lr + li * li;
        const float zr = ((ar - 1.0f) * lr + ai * li) / den, zi = (ai * lr - (ar - 1.0f) * li) / den;
        const float* br = a.in[10] + ((size_t)(l * 32 + g) * 64 + n) * 16; const float* bi = a.in[11] + ((size_t)(l * 32 + g) * 64 + n) * 16;
        bf16* ore = (bf16*)(ws + WS_S5B) + ((size_t)(l * 32 + g) * 128 + n) * 16; bf16* oim = ore + 64 * 16;
#pragma unroll
        for (int c = 0; c < 16; ++c) { const float r_ = br[c], i_ = bi[c]; ore[c] = (bf16)f2bf(zr * r_ - zi * i_); oim[c] = (bf16)f2bf(zr * i_ + zi * r_); } }
    { const float* x = a.in[0]; bf16* xb = (bf16*)(ws + WS_XB);
      for (int row = gw; row < M; row += NGW) {
          const f32x4* xr = (const f32x4*)(x + (size_t)row * D) + lane; float s = 0.f;
          v2u* o8 = (v2u*)(xb + (size_t)row * D) + lane;
#pragma unroll
          for (int j = 0; j < 8; ++j) { const f32x4 v = xr[64 * j]; s += (v[0] * v[0] + v[1] * v[1]) + (v[2] * v[2] + v[3] * v[3]); v2u w; w.x = pk2(v[0], v[1]); w.y = pk2(v[2], v[3]); o8[64 * j] = w; }
          s = wave_sum(s); if (lane == 0) ssq[row] = s; } }
}
constexpr int I_IN = 32 * 200, I_BR = 8 * 32, I_OUT = 32 * 32, I_GU = 32 * 176, I_DN = 88 * 32, I_GLU = 8 * 8;
constexpr int I_LAYER = I_IN + 4 * I_BR + I_OUT + I_GU + I_DN + I_GLU;
__device__ __forceinline__ void weight_jobs(const Args& a, unsigned char* lds, int l, int lo, int hi, int worker, int nworkers, int lane, int wave) {
    unsigned char* ws = a.ws;
    float* scr = (float*)(lds + wave * 16640);
    unsigned char* wt = ws + WS_WT + (size_t)l * WT_LAYER;
    for (int it = lo + worker; it < hi; it += nworkers) {
        int r = it;
        if (r < I_IN) { const float* w = a.in[3] + (size_t)l * D * DIN;
            transpose_item<1>(w, nullptr, DIN, a.in[2] + l * D, (bf16*)(wt + WT_IN), D, 0, 200, scr, r, lane); continue; }
        r -= I_IN;
        if (r < 4 * I_BR) { const int m = r / I_BR; const float* w = a.in[18] + ((size_t)l * 4 + m) * 512 * D;
            transpose_item<0>(w, nullptr, D, nullptr, (bf16*)(wt + WT_BR), D, m * 512, 32, scr, r % I_BR, lane); continue; }
        r -= 4 * I_BR;
        if (r < I_OUT) { const float* w = a.in[19] + (size_t)l * D * D;
            transpose_item<0>(w, nullptr, D, nullptr, (bf16*)(wt + WT_OUT), D, 0, 32, scr, r, lane); continue; }
        r -= I_OUT;
        if (r < I_GU) { const float* wg = a.in[21] + (size_t)l * D * FF; const float* wu = a.in[22] + (size_t)l * D * FF;
            transpose_item<2>(wg, wu, FF, a.in[20] + l * D, (bf16*)(wt + WT_GU), D, 0, 176, scr, r, lane); continue; }
        r -= I_GU;
        if (r < I_DN) { const float* w = a.in[23] + (size_t)l * FF * D;
            transpose_item<0>(w, nullptr, D, nullptr, (bf16*)(wt + WT_DN), FF, 0, 32, scr, r, lane); continue; }
        r -= I_DN;
        { const float* w = a.in[15] + (size_t)l * 512 * 512;
            transpose_item<0>(w, nullptr, 512, nullptr, (bf16*)(ws + WS_GLU) + (size_t)l * 512 * 512, 512, 0, 8, scr, r, lane); }
    }
}

constexpr int ATT_BUF = 70656;
struct AttnUnit { int cfg, b, h, dil, r, nb; };
__device__ __forceinline__ AttnUnit attn_decode(int unit) {
    AttnUnit A; A.cfg = unit >> 9; int rem = unit & 511; A.b = rem >> 8; rem &= 255; A.h = rem >> 5; const int blk = rem & 31;
    A.dil = A.cfg == 1 ? 4 : A.cfg == 2 ? 16 : 1; const int nbr = 32 / A.dil; A.r = blk / nbr; A.nb = blk % nbr; return A;
}
struct AttnRegs { v4u k[4], v[4]; bf16x8 q0, q1; };
__device__ __forceinline__ void attn_issue(const Args& a, int unit, AttnRegs& R, int tid, int lane, int wave) {
    const AttnUnit A = attn_decode(unit);
    const bf16* abf = (const bf16*)(a.ws + WS_ABF);
    const int qoff = A.cfg < 3 ? A.h * 64 : 1536 + A.h * 64;
    const int koff = A.cfg < 3 ? 512 + A.h * 64 : 2048 + (A.h >> 2) * 64;
    const int voff = A.cfg < 3 ? 1024 + A.h * 64 : 2176 + (A.h >> 2) * 64;
    const int kj = tid >> 1, half = tid & 1; const int si = A.nb * 128 - 128 + kj;
    if (si >= 0) {
        const size_t tok = (size_t)(A.b * SEQ + si * A.dil + A.r);
        const v4u* kp = (const v4u*)(abf + tok * 2304 + koff + half * 32); const v4u* vp = (const v4u*)(abf + tok * 2304 + voff + half * 32);
#pragma unroll
        for (int i = 0; i < 4; ++i) { R.k[i] = kp[i]; R.v[i] = vp[i]; }
    } else {
#pragma unroll
        for (int i = 0; i < 4; ++i) { R.k[i] = (v4u){0u, 0u, 0u, 0u}; R.v[i] = (v4u){0u, 0u, 0u, 0u}; }
    }
    const int fr = lane & 15, fq = lane >> 4;
    const size_t tokq = (size_t)(A.b * SEQ + (A.nb * 128 + 16 * wave + fr) * A.dil + A.r);
    const bf16* qp = abf + tokq * 2304 + qoff + 8 * fq;
    R.q0 = *(const bf16x8*)qp; R.q1 = *(const bf16x8*)(qp + 32);
}
__device__ __forceinline__ void attn_store(const AttnRegs& R, unsigned char* buf, int tid) {
    bf16* Ks = (bf16*)buf; bf16* Vt = Ks + 256 * 72;
    const int kj = tid >> 1, half = tid & 1;
    v4u* kd = (v4u*)(Ks + kj * 72 + half * 32);
#pragma unroll
    for (int i = 0; i < 4; ++i) kd[i] = R.k[i];
#pragma unroll
    for (int i = 0; i < 4; ++i) {
        const unsigned w[4] = {R.v[i].x, R.v[i].y, R.v[i].z, R.v[i].w};
#pragma unroll
        for (int j = 0; j < 4; ++j) { Vt[(half * 32 + 8 * i + 2 * j) * 264 + kj] = (bf16)(w[j] & 0xffffu); Vt[(half * 32 + 8 * i + 2 * j + 1) * 264 + kj] = (bf16)(w[j] >> 16); }
    }
}
__device__ __forceinline__ void attn_compute(const Args& a, int layer, int unit, const unsigned char* buf, const bf16x8 qf0, const bf16x8 qf1, int lane, int wave) {
    unsigned char* ws = a.ws;
    const AttnUnit A = attn_decode(unit);
    const int maxd = A.cfg == 3 ? 127 : 128;
    const bf16* Ks = (const bf16*)buf; const bf16* Vt = Ks + 256 * 72;
    const int fr = lane & 15, fq = lane >> 4;
    const int qi = 16 * wave + fr; const int tokq = A.b * SEQ + (A.nb * 128 + qi) * A.dil + A.r;
    const int ts = wave < 6 ? wave : 6;
    f32x4 s[10];
#pragma unroll
    for (int i = 0; i < 10; ++i) {
        const bf16* kr = Ks + ((ts + i) * 16 + fr) * 72 + 8 * fq;
        const bf16x8 k0 = *(const bf16x8*)kr, k1 = *(const bf16x8*)(kr + 32);
        f32x4 z = (f32x4){0.f, 0.f, 0.f, 0.f};
        z = __builtin_amdgcn_mfma_f32_16x16x32_bf16(k0, qf0, z, 0, 0, 0);
        s[i] = __builtin_amdgcn_mfma_f32_16x16x32_bf16(k1, qf1, z, 0, 0, 0);
    }
    float mx = -INFINITY;
#pragma unroll
    for (int i = 0; i < 10; ++i)
#pragma unroll
        for (int j = 0; j < 4; ++j) {
            const int kj = (ts + i) * 16 + 4 * fq + j; const int dist = 128 + qi - kj;
            const bool valid = (dist >= 0) && (dist <= maxd) && (A.nb * 128 - 128 + kj >= 0);
            const float v = valid ? s[i][j] : -INFINITY; s[i][j] = v; mx = fmaxf(mx, v);
        }
    mx = fmaxf(mx, __shfl_xor(mx, 16)); mx = fmaxf(mx, __shfl_xor(mx, 32));
    float l = 0.f;
#pragma unroll
    for (int i = 0; i < 10; ++i)
#pragma unroll
        for (int j = 0; j < 4; ++j) { const float p = __expf(s[i][j] - mx); s[i][j] = p; l += p; }
    l += __shfl_xor(l, 16); l += __shfl_xor(l, 32);
    f32x4 o[4];
#pragma unroll
    for (int dt = 0; dt < 4; ++dt) o[dt] = (f32x4){0.f, 0.f, 0.f, 0.f};
#pragma unroll
    for (int p = 0; p < 5; ++p) {
        bf16x8 pf;
        { const unsigned w0 = pk2(s[2 * p][0], s[2 * p][1]), w1 = pk2(s[2 * p][2], s[2 * p][3]), w2 = pk2(s[2 * p + 1][0], s[2 * p + 1][1]), w3 = pk2(s[2 * p + 1][2], s[2 * p + 1][3]);
          pf[0] = (short)(w0 & 0xffff); pf[1] = (short)(w0 >> 16); pf[2] = (short)(w1 & 0xffff); pf[3] = (short)(w1 >> 16);
          pf[4] = (short)(w2 & 0xffff); pf[5] = (short)(w2 >> 16); pf[6] = (short)(w3 & 0xffff); pf[7] = (short)(w3 >> 16); }
#pragma unroll
        for (int dt = 0; dt < 4; ++dt) {
            const bf16* vr = Vt + (dt * 16 + fr) * 264 + (ts + 2 * p) * 16 + 4 * fq;
            const s16x4 v0 = *(const s16x4*)vr, v1 = *(const s16x4*)(vr + 16);
            bf16x8 vf; vf[0] = v0[0]; vf[1] = v0[1]; vf[2] = v0[2]; vf[3] = v0[3]; vf[4] = v1[0]; vf[5] = v1[1]; vf[6] = v1[2]; vf[7] = v1[3];
            o[dt] = __builtin_amdgcn_mfma_f32_16x16x32_bf16(vf, pf, o[dt], 0, 0, 0);
        }
    }
    if (A.cfg == 3) {
        const float lse = mx + __logf(l); const float sink = a.in[17][layer * 8 + A.h];
        const float sc = __frcp_rn(1.0f + __expf(sink - lse)) / l;
        bf16* brp = (bf16*)(ws + WS_BR) + (size_t)tokq * 2048 + 1536 + A.h * 64 + 4 * fq;
#pragma unroll
        for (int dt = 0; dt < 4; ++dt) { v2u w; w.x = pk2(o[dt][0] * sc, o[dt][1] * sc); w.y = pk2(o[dt][2] * sc, o[dt][3] * sc); *(v2u*)(brp + dt * 16) = w; }
    } else {
        bf16* op = (bf16*)(ws + WS_OPART) + ((size_t)A.cfg * M + tokq) * 512 + A.h * 64 + 4 * fq;
#pragma unroll
        for (int dt = 0; dt < 4; ++dt) { v2u w; w.x = pk2(o[dt][0], o[dt][1]); w.y = pk2(o[dt][2], o[dt][3]); *(v2u*)(op + dt * 16) = w; }
        if (fq == 0) { float* mlp = (float*)(ws + WS_ML) + (((size_t)A.cfg * M + tokq) * 8 + A.h) * 2; mlp[0] = mx; mlp[1] = l; }
    }
}
__device__ __forceinline__ void attn_phase(const Args& a, int layer, unsigned* cnt, unsigned char* lds, int tid, int lane, int wave) {
    volatile int* su = (volatile int*)(lds + 143360);
    if (tid == 0) { su[0] = (int)atomicAdd(cnt, 1u); su[1] = (int)atomicAdd(cnt, 1u); }
    __syncthreads();
    int ucur = su[0], unxt = su[1];
    if (ucur >= 2048) return;
    AttnRegs R; bf16x8 qc0, qc1;
    attn_issue(a, ucur, R, tid, lane, wave); attn_store(R, lds, tid); qc0 = R.q0; qc1 = R.q1;
    __syncthreads();
    int p = 0;
    for (;;) {
        if (tid == 0) su[p] = (int)atomicAdd(cnt, 1u);
        const bool hn = unxt < 2048;
        if (hn) attn_issue(a, unxt, R, tid, lane, wave);
        attn_compute(a, layer, ucur, lds + p * ATT_BUF, qc0, qc1, lane, wave);
        if (hn) { attn_store(R, lds + (p ^ 1) * ATT_BUF, tid); qc0 = R.q0; qc1 = R.q1; }
        __syncthreads();
        ucur = unxt; unxt = su[p]; p ^= 1;
        if (ucur >= 2048) break;
    }
}

__device__ __forceinline__ void dil_merge(const Args& a, int gtid, int NGT) {
    unsigned char* ws = a.ws;
    const bf16* opart = (const bf16*)(ws + WS_OPART); const float* ml = (const float*)(ws + WS_ML);
    bf16* br = (bf16*)(ws + WS_BR);
    for (int it = gtid; it < M * 64; it += NGT) {
        const int tok = it >> 6, c8 = it & 63, h = c8 >> 3;
        float m[3], l[3];
#pragma unroll
        for (int c = 0; c < 3; ++c) { const float* p = ml + (((size_t)c * M + tok) * 8 + h) * 2; m[c] = p[0]; l[c] = p[1]; }
        const float mm = fmaxf(m[0], fmaxf(m[1], m[2]));
        float w[3], den = 0.f;
#pragma unroll
        for (int c = 0; c < 3; ++c) { w[c] = __expf(m[c] - mm); den += w[c] * l[c]; }
        const float inv = 1.0f / den;
        float acc[8];
#pragma unroll
        for (int i = 0; i < 8; ++i) acc[i] = 0.f;
#pragma unroll
        for (int c = 0; c < 3; ++c) { const v4u x = *(const v4u*)(opart + ((size_t)c * M + tok) * 512 + c8 * 8);
            acc[0] += w[c] * __uint_as_float(x.x << 16); acc[1] += w[c] * __uint_as_float(x.x & 0xffff0000u); acc[2] += w[c] * __uint_as_float(x.y << 16); acc[3] += w[c] * __uint_as_float(x.y & 0xffff0000u);
            acc[4] += w[c] * __uint_as_float(x.z << 16); acc[5] += w[c] * __uint_as_float(x.z & 0xffff0000u); acc[6] += w[c] * __uint_as_float(x.w << 16); acc[7] += w[c] * __uint_as_float(x.w & 0xffff0000u); }
        v4u o; o.x = pk2(acc[0] * inv, acc[1] * inv); o.y = pk2(acc[2] * inv, acc[3] * inv); o.z = pk2(acc[4] * inv, acc[5] * inv); o.w = pk2(acc[6] * inv, acc[7] * inv);
        *(v4u*)(br + (size_t)tok * 2048 + 1024 + c8 * 8) = o;
    }
}

__device__ __forceinline__ v4u pack8(const float (&x)[8]) { v4u w; w.x = pk2(x[0], x[1]); w.y = pk2(x[2], x[3]); w.z = pk2(x[4], x[5]); w.w = pk2(x[6], x[7]); return w; }
__device__ __forceinline__ void gla_g1(const Args& a, int layer, int unit, unsigned char* lds, int tid, int lane, int wave) {
    const int bh = unit >> 6, n = unit & 63, b = bh >> 2, h = bh & 3;
    bf16* keT = (bf16*)lds;
    bf16* vT = keT + 64 * 72;
    float* tot = (float*)(lds + 32768);
    float* lastb = tot + 512;
    float* cumL = (float*)(lds + 36864);
    const float* projm = (const float*)(a.ws + WS_PROJM);
    float* gcum = (float*)(a.ws + WS_GCUM);
    const int t_ = tid >> 3, c8 = tid & 7; const size_t tok_ = (size_t)(b * SEQ + n * 64 + t_);
    const f32x4 kr0 = *(const f32x4*)(projm + tok_ * NMIX + C_GK + h * 64 + 8 * c8), kr1 = *(const f32x4*)(projm + tok_ * NMIX + C_GK + h * 64 + 8 * c8 + 4);
    f32x4 vr[4];
#pragma unroll
    for (int i = 0; i < 4; ++i) vr[i] = *(const f32x4*)(projm + tok_ * NMIX + C_GV + h * 128 + 16 * c8 + 4 * i);
    {
        const float* a2 = a.in[4] + (size_t)layer * 16 * 256; const float* ab = a.in[5] + layer * 256;
        const int k = tid & 63, tg = tid >> 6;
        float w[16];
#pragma unroll
        for (int r = 0; r < 16; ++r) w[r] = a2[r * 256 + h * 64 + k];
        const float bias = ab[h * 64 + k];
        float p[8]; float run = 0.f;
#pragma unroll
        for (int i = 0; i < 8; ++i) {
            const size_t tok = (size_t)(b * SEQ + n * 64 + tg * 8 + i);
            const f32x4* gp = (const f32x4*)(projm + tok * NMIX + C_LR);
            float z = bias;
#pragma unroll
            for (int q = 0; q < 4; ++q) { const f32x4 g4 = gp[q]; z += g4[0] * w[4 * q] + g4[1] * w[4 * q + 1] + g4[2] * w[4 * q + 2] + g4[3] * w[4 * q + 3]; }
            const float ls = fminf(z, 0.f) - __logf(1.0f + __expf(-fabsf(z)));
            run += ls * (1.0f / 16.0f); p[i] = run;
        }
        tot[tg * 64 + k] = run;
        __syncthreads();
        float off = 0.f;
#pragma unroll
        for (int g = 0; g < 7; ++g) off += (g < tg) ? tot[g * 64 + k] : 0.f;
#pragma unroll
        for (int i = 0; i < 8; ++i) { const float c = off + p[i]; const int t = tg * 8 + i; cumL[t * 65 + k] = c; gcum[(size_t)(b * SEQ + n * 64 + t) * 256 + h * 64 + k] = c; }
        if (tg == 7) { lastb[k] = off + p[7]; ((float*)(a.ws + WS_GLAST))[unit * 64 + k] = off + p[7]; }
    }
    __syncthreads();
    {
        const float kx[8] = {kr0[0], kr0[1], kr0[2], kr0[3], kr1[0], kr1[1], kr1[2], kr1[3]};
#pragma unroll
        for (int j = 0; j < 8; ++j) { const int kk = 8 * c8 + j; keT[kk * 72 + t_] = (bf16)f2bf(kx[j] * __expf(lastb[kk] - cumL[t_ * 65 + kk])); }
#pragma unroll
        for (int i = 0; i < 4; ++i)
#pragma unroll
            for (int j = 0; j < 4; ++j) vT[(16 * c8 + 4 * i + j) * 72 + t_] = (bf16)f2bf(vr[i][j]);
    }
    __syncthreads();
    {
        const int fr = lane & 15, fq = lane >> 4;
        f32x4 acc[4];
#pragma unroll
        for (int kt = 0; kt < 4; ++kt) acc[kt] = (f32x4){0.f, 0.f, 0.f, 0.f};
#pragma unroll
        for (int ts = 0; ts < 2; ++ts) {
            const bf16x8 bfv = *(const bf16x8*)(vT + (wave * 16 + fr) * 72 + 32 * ts + 8 * fq);
#pragma unroll
            for (int kt = 0; kt < 4; ++kt) { const bf16x8 af = *(const bf16x8*)(keT + (kt * 16 + fr) * 72 + 32 * ts + 8 * fq); acc[kt] = __builtin_amdgcn_mfma_f32_16x16x32_bf16(af, bfv, acc[kt], 0, 0, 0); }
        }
        float* kvo = (float*)(a.ws + WS_GKV) + (size_t)unit * 64 * 128 + wave * 16 + fr;
#pragma unroll
        for (int kt = 0; kt < 4; ++kt)
#pragma unroll
            for (int j = 0; j < 4; ++j) kvo[(kt * 16 + 4 * fq + j) * 128] = acc[kt][j];
    }
    __syncthreads();
}
__device__ __forceinline__ void gla_g2(const Args& a, int idx) {
    const int bh = idx >> 13, k = (idx >> 7) & 63, v = idx & 127;
    const float* kv = (const float*)(a.ws + WS_GKV); const float* last = (const float*)(a.ws + WS_GLAST); float* st = (float*)(a.ws + WS_GST);
    float S = 0.f;
    for (int n0 = 0; n0 < 64; n0 += 16) {
        float kvv[16], dd[16];
#pragma unroll
        for (int i = 0; i < 16; ++i) { const int u = bh * 64 + n0 + i; kvv[i] = kv[((size_t)u * 64 + k) * 128 + v]; dd[i] = last[u * 64 + k]; }
#pragma unroll
        for (int i = 0; i < 16; ++i) { const int u = bh * 64 + n0 + i; st[((size_t)u * 64 + k) * 128 + v] = S; S = S * __expf(dd[i]) + kvv[i]; }
    }
}
constexpr int G3_BUF = 55296;
struct G3Regs { f32x4 c0, c1, r0, r1, q0, q1, k0, k1, v[4], s[4]; float rk; };
__device__ __forceinline__ void g3_issue(const Args& a, int unit, G3Regs& R, int tid) {
    const int bh = unit >> 6, n = unit & 63, b = bh >> 2, h = bh & 3;
    const float* projm = (const float*)(a.ws + WS_PROJM); const float* gcum = (const float*)(a.ws + WS_GCUM);
    const int t_ = tid >> 3, c8 = tid & 7; const size_t tok_ = (size_t)(b * SEQ + n * 64 + t_), tok31 = (size_t)(b * SEQ + n * 64 + 31);
    R.c0 = *(const f32x4*)(gcum + tok_ * 256 + h * 64 + 8 * c8); R.c1 = *(const f32x4*)(gcum + tok_ * 256 + h * 64 + 8 * c8 + 4);
    R.r0 = *(const f32x4*)(gcum + tok31 * 256 + h * 64 + 8 * c8); R.r1 = *(const f32x4*)(gcum + tok31 * 256 + h * 64 + 8 * c8 + 4);
    R.rk = gcum[tok31 * 256 + h * 64 + t_];
    R.q0 = *(const f32x4*)(projm + tok_ * NMIX + C_GQ + h * 64 + 8 * c8); R.q1 = *(const f32x4*)(projm + tok_ * NMIX + C_GQ + h * 64 + 8 * c8 + 4);
    R.k0 = *(const f32x4*)(projm + tok_ * NMIX + C_GK + h * 64 + 8 * c8); R.k1 = *(const f32x4*)(projm + tok_ * NMIX + C_GK + h * 64 + 8 * c8 + 4);
    const float* stp = (const float*)(a.ws + WS_GST) + (size_t)unit * 64 * 128 + t_ * 128 + 16 * c8;
#pragma unroll
    for (int i = 0; i < 4; ++i) { R.v[i] = *(const f32x4*)(projm + tok_ * NMIX + C_GV + h * 128 + 16 * c8 + 4 * i); R.s[i] = *(const f32x4*)(stp + 4 * i); }
}
__device__ __forceinline__ void g3_stage(const G3Regs& R, unsigned char* buf, int tid) {
    bf16* qeL = (bf16*)buf; bf16* keL = qeL + 64 * 72; bf16* vT = keL + 64 * 72; bf16* SsT = vT + 128 * 72;
    const int t_ = tid >> 3, c8 = tid & 7;
    const float cc[8] = {R.c0[0], R.c0[1], R.c0[2], R.c0[3], R.c1[0], R.c1[1], R.c1[2], R.c1[3]};
    const float rr[8] = {R.r0[0], R.r0[1], R.r0[2], R.r0[3], R.r1[0], R.r1[1], R.r1[2], R.r1[3]};
    const float qq[8] = {R.q0[0], R.q0[1], R.q0[2], R.q0[3], R.q1[0], R.q1[1], R.q1[2], R.q1[3]};
    const float kk[8] = {R.k0[0], R.k0[1], R.k0[2], R.k0[3], R.k1[0], R.k1[1], R.k1[2], R.k1[3]};
    float qe[8], ke[8];
#pragma unroll
    for (int j = 0; j < 8; ++j) { const float d = cc[j] - rr[j]; qe[j] = qq[j] * 0.125f * __expf(d); ke[j] = kk[j] * __expf(-d); }
    *(v4u*)(qeL + t_ * 72 + 8 * c8) = pack8(qe); *(v4u*)(keL + t_ * 72 + 8 * c8) = pack8(ke);
    const float sc = __expf(R.rk);
#pragma unroll
    for (int i = 0; i < 4; ++i)
#pragma unroll
        for (int j = 0; j < 4; ++j) { vT[(16 * c8 + 4 * i + j) * 72 + t_] = (bf16)f2bf(R.v[i][j]); SsT[(16 * c8 + 4 * i + j) * 72 + t_] = (bf16)f2bf(R.s[i][j] * sc); }
}
__device__ __forceinline__ void g3_compute(const Args& a, int layer, int unit, const unsigned char* buf, float* ssb, int lane, int wave) {
    const int bh = unit >> 6, n = unit & 63, b = bh >> 2, h = bh & 3;
    const bf16* qeL = (const bf16*)buf; const bf16* keL = qeL + 64 * 72; const bf16* vT = keL + 64 * 72; const bf16* SsT = vT + 128 * 72;
    const int fr = lane & 15, fq = lane >> 4, tt = wave & 3, vh = wave >> 2;
    bf16x8 qf[2];
#pragma unroll
    for (int ks = 0; ks < 2; ++ks) qf[ks] = *(const bf16x8*)(qeL + (tt * 16 + fr) * 72 + 32 * ks + 8 * fq);
    f32x4 sT[4];
#pragma unroll
    for (int jt = 0; jt < 4; ++jt) {
        f32x4 z = (f32x4){0.f, 0.f, 0.f, 0.f};
        if (jt <= tt) {
#pragma unroll
            for (int ks = 0; ks < 2; ++ks) { const bf16x8 kf = *(const bf16x8*)(keL + (jt * 16 + fr) * 72 + 32 * ks + 8 * fq); z = __builtin_amdgcn_mfma_f32_16x16x32_bf16(kf, qf[ks], z, 0, 0, 0); }
#pragma unroll
            for (int jj = 0; jj < 4; ++jj) if (jt * 16 + 4 * fq + jj > tt * 16 + fr) z[jj] = 0.f;
        }
        sT[jt] = z;
    }
    f32x4 o[4];
#pragma unroll
    for (int vt = 0; vt < 4; ++vt) o[vt] = (f32x4){0.f, 0.f, 0.f, 0.f};
#pragma unroll
    for (int p = 0; p < 2; ++p) {
        bf16x8 pf;
        { const unsigned w0 = pk2(sT[2 * p][0], sT[2 * p][1]), w1 = pk2(sT[2 * p][2], sT[2 * p][3]), w2 = pk2(sT[2 * p + 1][0], sT[2 * p + 1][1]), w3 = pk2(sT[2 * p + 1][2], sT[2 * p + 1][3]);
          pf[0] = (short)(w0 & 0xffff); pf[1] = (short)(w0 >> 16); pf[2] = (short)(w1 & 0xffff); pf[3] = (short)(w1 >> 16);
          pf[4] = (short)(w2 & 0xffff); pf[5] = (short)(w2 >> 16); pf[6] = (short)(w3 & 0xffff); pf[7] = (short)(w3 >> 16); }
#pragma unroll
        for (int vt = 0; vt < 4; ++vt) {
            const bf16* vr = vT + ((4 * vh + vt) * 16 + fr) * 72 + 32 * p + 4 * fq;
            const s16x4 v0 = *(const s16x4*)vr, v1 = *(const s16x4*)(vr + 16);
            bf16x8 vf; vf[0] = v0[0]; vf[1] = v0[1]; vf[2] = v0[2]; vf[3] = v0[3]; vf[4] = v1[0]; vf[5] = v1[1]; vf[6] = v1[2]; vf[7] = v1[3];
            o[vt] = __builtin_amdgcn_mfma_f32_16x16x32_bf16(vf, pf, o[vt], 0, 0, 0);
        }
    }
#pragma unroll
    for (int ks = 0; ks < 2; ++ks)
#pragma unroll
        for (int vt = 0; vt < 4; ++vt) { const bf16x8 sf = *(const bf16x8*)(SsT + ((4 * vh + vt) * 16 + fr) * 72 + 32 * ks + 8 * fq); o[vt] = __builtin_amdgcn_mfma_f32_16x16x32_bf16(sf, qf[ks], o[vt], 0, 0, 0); }
    float ss = 0.f;
#pragma unroll
    for (int vt = 0; vt < 4; ++vt) ss += (o[vt][0] * o[vt][0] + o[vt][1] * o[vt][1]) + (o[vt][2] * o[vt][2] + o[vt][3] * o[vt][3]);
    ss += __shfl_xor(ss, 16); ss += __shfl_xor(ss, 32);
    if (fq == 0) ssb[vh * 64 + tt * 16 + fr] = ss;
    __syncthreads();
    const float rstd = rsqrtf((ssb[tt * 16 + fr] + ssb[64 + tt * 16 + fr]) * (1.0f / 128.0f) + 1e-6f);
    const size_t tok = (size_t)(b * SEQ + n * 64 + tt * 16 + fr);
    const float* projm = (const float*)(a.ws + WS_PROJM);
#pragma unroll
    for (int vt = 0; vt < 4; ++vt) { const int v0 = (4 * vh + vt) * 16 + 4 * fq;
        const f32x4 gn = *(const f32x4*)(a.in[6] + (size_t)layer * 512 + h * 128 + v0); const f32x4 gr = *(const f32x4*)(projm + tok * NMIX + C_GR + h * 128 + v0);
        float ov[4];
#pragma unroll
        for (int jj = 0; jj < 4; ++jj) { const float g = gr[jj]; ov[jj] = o[vt][jj] * rstd * gn[jj] * (g * __frcp_rn(1.0f + __expf(-g))); }
        v2u w; w.x = pk2(ov[0], ov[1]); w.y = pk2(ov[2], ov[3]);
        *(v2u*)((bf16*)(a.ws + WS_BR) + tok * 2048 + h * 128 + v0) = w; }
}
__device__ __forceinline__ void g3_phase(const Args& a, int layer, unsigned char* lds, int tid, int lane, int wave, int bid, int G) {
    float* ssb = (float*)(lds + 2 * G3_BUF);
    int u = bid; if (u >= 512) return;
    G3Regs R; g3_issue(a, u, R, tid); g3_stage(R, lds, tid);
    __syncthreads();
    int p = 0;
    for (;;) {
        const int un = u + G; const bool hn = un < 512;
        if (hn) g3_issue(a, un, R, tid);
        g3_compute(a, layer, u, lds + p * G3_BUF, ssb + p * 128, lane, wave);
        if (hn) g3_stage(R, lds + (p ^ 1) * G3_BUF, tid);
        __syncthreads();
        if (!hn) break;
        u = un; p ^= 1;
    }
}

constexpr int S5_LC = 32, S5_NC = SEQ / S5_LC;
constexpr int XP = 132;
__device__ __forceinline__ bf16x8 cvt8(const f32x4 a0, const f32x4 a1) {
    bf16x8 r; const unsigned w0 = pk2(a0[0], a0[1]), w1 = pk2(a0[2], a0[3]), w2 = pk2(a1[0], a1[1]), w3 = pk2(a1[2], a1[3]);
    r[0] = (short)(w0 & 0xffff); r[1] = (short)(w0 >> 16); r[2] = (short)(w1 & 0xffff); r[3] = (short)(w1 >> 16);
    r[4] = (short)(w2 & 0xffff); r[5] = (short)(w2 >> 16); r[6] = (short)(w3 & 0xffff); r[7] = (short)(w3 >> 16); return r;
}
template <bool WITH_Y>
__device__ __forceinline__ void s5_group(const Args& a, int layer, int b, int ch, int g, float* xb_, bf16* zb, float& hr, float& hi, int lane) {
    const float* projm = (const float*)(a.ws + WS_PROJM);
    const int fr = lane & 15, fq = lane >> 4;
    const f32x4 ap = *(const f32x4*)((const float*)(a.ws + WS_S5A) + ((size_t)(layer * 32 + g) * 64 + lane) * 4);
    const float ar = ap[0], ai = ap[1];
    bf16x8 bbf[8];
    {   const bf16* bp = (const bf16*)(a.ws + WS_S5B) + ((size_t)(layer * 32 + g) * 128 + fr) * 16 + 8 * (fq & 1);
#pragma unroll
        for (int tl = 0; tl < 8; ++tl) { bf16x8 v = *(const bf16x8*)(bp + tl * 256); if (fq >= 2) v = (bf16x8){0, 0, 0, 0, 0, 0, 0, 0}; bbf[tl] = v; } }
    bf16x8 cf[4]; f32x4 dd4 = (f32x4){0.f, 0.f, 0.f, 0.f};
    if (WITH_Y) {
        const float* crp = a.in[12] + ((size_t)(layer * 32 + g) * 16 + fr) * 64; const float* cip = a.in[13] + ((size_t)(layer * 32 + g) * 16 + fr) * 64;
#pragma unroll
        for (int ks = 0; ks < 2; ++ks) { const f32x4 r0 = *(const f32x4*)(crp + 32 * ks + 8 * fq), r1 = *(const f32x4*)(crp + 32 * ks + 8 * fq + 4); cf[ks] = cvt8(r0, r1);
            const f32x4 i0 = *(const f32x4*)(cip + 32 * ks + 8 * fq), i1 = *(const f32x4*)(cip + 32 * ks + 8 * fq + 4); cf[2 + ks] = cvt8(-i0, -i1); }
        dd4 = *(const f32x4*)(a.in[14] + (size_t)(layer * 32 + g) * 16 + 4 * fq);
    }
#pragma unroll 1
    for (int hf = 0; hf < 2; ++hf) {
        const int tok = b * SEQ + ch * S5_LC + hf * 16 + fr;
        const float* up = projm + (size_t)tok * NMIX + C_S5 + g * 16;
        bf16x8 uf = (bf16x8){0, 0, 0, 0, 0, 0, 0, 0};
        if (fq < 2) uf = cvt8(*(const f32x4*)(up + 8 * fq), *(const f32x4*)(up + 8 * fq + 4));
        f32x4 u4 = (f32x4){0.f, 0.f, 0.f, 0.f};
        if (WITH_Y) u4 = *(const f32x4*)(up + 4 * fq);
#pragma unroll
        for (int tl = 0; tl < 8; ++tl) {
            const f32x4 xo = __builtin_amdgcn_mfma_f32_16x16x32_bf16(uf, bbf[tl], (f32x4){0.f, 0.f, 0.f, 0.f}, 0, 0, 0);
#pragma unroll
            for (int j = 0; j < 4; ++j) xb_[(4 * fq + j) * XP + tl * 16 + fr] = xo[j];
        }
        LDS_WAIT(); asm volatile("" ::: "memory");
#pragma unroll
        for (int t = 0; t < 16; ++t) {
            const float xr = xb_[t * XP + lane], xi = xb_[t * XP + 64 + lane];
            const float nr = ar * hr - ai * hi + xr, ni = ar * hi + ai * hr + xi; hr = nr; hi = ni;
            if (WITH_Y) { xb_[t * XP + lane] = hr; xb_[t * XP + 64 + lane] = hi; }
        }
        LDS_WAIT(); asm volatile("" ::: "memory");
        if (WITH_Y) {
            f32x4 y = (f32x4){0.f, 0.f, 0.f, 0.f};
#pragma unroll
            for (int ks = 0; ks < 4; ++ks) { const float* hp = xb_ + fr * XP + 32 * ks + 8 * fq; const bf16x8 hf8 = cvt8(*(const f32x4*)hp, *(const f32x4*)(hp + 4));
                y = __builtin_amdgcn_mfma_f32_16x16x32_bf16(cf[ks], hf8, y, 0, 0, 0); }
            LDS_WAIT(); asm volatile("" ::: "memory");
            float z[4];
#pragma unroll
            for (int j = 0; j < 4; ++j) { const float yy = y[j] + dd4[j] * u4[j];
                const float in = 0.7978845608028654f * (yy + 0.044715f * yy * yy * yy);
                const float th = 1.0f - 2.0f * __frcp_rn(__expf(2.0f * in) + 1.0f);
                z[j] = 0.5f * yy * (1.0f + th); }
            v2u w; w.x = pk2(z[0], z[1]); w.y = pk2(z[2], z[3]);
            *(v2u*)(zb + (hf * 16 + fr) * 520 + g * 16 + 4 * fq) = w;
        }
    }
}
__device__ __forceinline__ void s5_s1(const Args& a, int layer, int unit, unsigned char* lds, int tid, int lane, int wave) {
    const int ch = unit & 127, b = unit >> 7;
    float* xw = (float*)lds + wave * (16 * XP);
#pragma unroll 1
    for (int gi = 0; gi < 4; ++gi) {
        const int g = wave * 4 + gi;
        float hr = 0.f, hi = 0.f;
        s5_group<false>(a, layer, b, ch, g, xw, nullptr, hr, hi, lane);
        v2u w; w.x = __float_as_uint(hr); w.y = __float_as_uint(hi);
        *(v2u*)((float*)(a.ws + WS_S5E) + ((((size_t)b * 32 + g) * S5_NC + ch) * 64 + lane) * 2) = w;
    }
}
__device__ __forceinline__ void s5_s2(const Args& a, int layer, int idx) {
    const int n = idx & 63, g = (idx >> 6) & 31, b = idx >> 11;
    const f32x4 ap = *(const f32x4*)((const float*)(a.ws + WS_S5A) + ((size_t)(layer * 32 + g) * 64 + n) * 4);
    const float pr = ap[2], pi = ap[3];
    const float* e = (const float*)(a.ws + WS_S5E) + (((size_t)b * 32 + g) * S5_NC * 64 + n) * 2;
    float* c = (float*)(a.ws + WS_S5C) + (((size_t)b * 32 + g) * S5_NC * 64 + n) * 2;
    float hr = 0.f, hi = 0.f;
    for (int c0 = 0; c0 < S5_NC; c0 += 16) {
        float er[16], ei[16];
#pragma unroll
        for (int i = 0; i < 16; ++i) { const v2u w = *(const v2u*)(e + (size_t)(c0 + i) * 128); er[i] = __uint_as_float(w.x); ei[i] = __uint_as_float(w.y); }
#pragma unroll
        for (int i = 0; i < 16; ++i) { v2u w; w.x = __float_as_uint(hr); w.y = __float_as_uint(hi); *(v2u*)(c + (size_t)(c0 + i) * 128) = w;
            const float nr = pr * hr - pi * hi + er[i], ni = pr * hi + pi * hr + ei[i]; hr = nr; hi = ni; }
    }
}
__device__ __forceinline__ void s5_s3(const Args& a, int layer, int unit, unsigned char* lds, int tid, int lane, int wave) {
    const int ch = unit & 127, b = unit >> 7;
    float* xw = (float*)lds + wave * (16 * XP);
    bf16* zb = (bf16*)(lds + 69632);
#pragma unroll 1
    for (int gi = 0; gi < 4; ++gi) {
        const int g = wave * 4 + gi;
        const v2u cw = *(const v2u*)((const float*)(a.ws + WS_S5C) + ((((size_t)b * 32 + g) * S5_NC + ch) * 64 + lane) * 2);
        float hr = __uint_as_float(cw.x), hi = __uint_as_float(cw.y);
        s5_group<true>(a, layer, b, ch, g, xw, zb, hr, hi, lane);
    }
    __syncthreads();
    {
        const int fr = lane & 15, fq = lane >> 4;
        const bf16* Wt = (const bf16*)(a.ws + WS_GLU) + (size_t)layer * 512 * 512 + (size_t)(64 * wave + fr) * 512 + 8 * fq;
        const bf16* zr = zb + fr * 520 + 8 * fq;
        f32x4 acc[4][2];
#pragma unroll
        for (int nt = 0; nt < 4; ++nt) { acc[nt][0] = (f32x4){0.f, 0.f, 0.f, 0.f}; acc[nt][1] = (f32x4){0.f, 0.f, 0.f, 0.f}; }
#pragma unroll 4
        for (int ks = 0; ks < 16; ++ks) {
            bf16x8 af[4], bfr[2];
#pragma unroll
            for (int nt = 0; nt < 4; ++nt) af[nt] = *(const bf16x8*)(Wt + (size_t)nt * 16 * 512 + ks * 32);
#pragma unroll
            for (int tt = 0; tt < 2; ++tt) bfr[tt] = *(const bf16x8*)(zr + tt * 16 * 520 + ks * 32);
#pragma unroll
            for (int nt = 0; nt < 4; ++nt)
#pragma unroll
                for (int tt = 0; tt < 2; ++tt) acc[nt][tt] = __builtin_amdgcn_mfma_f32_16x16x32_bf16(af[nt], bfr[tt], acc[nt][tt], 0, 0, 0);
        }
        const float* bias = a.in[16] + layer * 512;
#pragma unroll
        for (int nt = 0; nt < 4; ++nt) { const int n0 = 64 * wave + 16 * nt + 4 * fq; const f32x4 b4 = *(const f32x4*)(bias + n0);
#pragma unroll
            for (int tt = 0; tt < 2; ++tt) { const int t = tt * 16 + fr; const v2u zz = *(const v2u*)(zb + t * 520 + n0);
                const float z0 = __uint_as_float(zz.x << 16), z1 = __uint_as_float(zz.x & 0xffff0000u), z2 = __uint_as_float(zz.y << 16), z3 = __uint_as_float(zz.y & 0xffff0000u);
                const f32x4 p = acc[nt][tt] + b4;
                v2u o; o.x = pk2(z0 * __frcp_rn(1.0f + __expf(-p[0])), z1 * __frcp_rn(1.0f + __expf(-p[1]))); o.y = pk2(z2 * __frcp_rn(1.0f + __expf(-p[2])), z3 * __frcp_rn(1.0f + __expf(-p[3])));
                *(v2u*)((bf16*)(a.ws + WS_BR) + (size_t)(b * SEQ + ch * S5_LC + t) * 2048 + 512 + n0) = o; } }
    }
    __syncthreads();
}

#define LAS __attribute__((address_space(3)))
#define XB_TMO      128
#define XB_XCNT(j)  (256  + 64 * (j))
#define XB_XSUB(j)  (1280 + 64 * (j))
#define XB_XGEN(j)  (2304 + 64 * (j))
#define XB_TOP      3328
#define XB_TOPGEN   3392
#define XB_SPIN_CAP (1u << 22)
__device__ __forceinline__ unsigned xb_ld(unsigned* p)              { return __hip_atomic_load(p, __ATOMIC_RELAXED, __HIP_MEMORY_SCOPE_AGENT); }
__device__ __forceinline__ unsigned xb_add(unsigned* p, unsigned v) { return __hip_atomic_fetch_add(p, v, __ATOMIC_RELAXED, __HIP_MEMORY_SCOPE_AGENT); }
__device__ __forceinline__ unsigned xb_xcc_id() { return (unsigned)__builtin_amdgcn_s_getreg((3 << 11) | 20) & 0xFu; }
#define XB_SPIN(cond, bar) do { unsigned _sp = 0; while (cond) { __builtin_amdgcn_s_sleep(1); \
    if ((++_sp & 255u) == 0u) { if (xb_ld(&(bar)[XB_TMO])) break; if (_sp > XB_SPIN_CAP) { atomicAdd(&(bar)[XB_TMO], 1u); break; } } } } while (0)
struct XcdBarrier { unsigned* bar; unsigned x; volatile LAS unsigned* st; };
__device__ __forceinline__ XcdBarrier xcd_barrier_post(unsigned* bar, volatile LAS unsigned* st) {
    XcdBarrier b; b.bar = bar; b.x = xb_xcc_id(); b.st = st;
    if (threadIdx.x == 0) (void)xb_add(&bar[XB_XCNT(b.x)], 1u);
    return b;
}
__device__ __forceinline__ void xcd_barrier_complete(unsigned* bar, unsigned x, unsigned& nloc, unsigned& nx) {
    const unsigned G = gridDim.x * gridDim.y * gridDim.z;
    unsigned sum, cnt, mine, sp = 0u;
    for (;;) {
        sum = 0u; cnt = 0u; mine = 0u;
#pragma unroll
        for (unsigned j = 0; j < 16; ++j) { const unsigned c = xb_ld(&bar[XB_XCNT(j)]); sum += c; cnt += (c > 0u) ? 1u : 0u; mine = (j == x) ? c : mine; }
        if (sum == G) break;
        __builtin_amdgcn_s_sleep(1);
        if ((++sp & 255u) == 0u) { if (xb_ld(&bar[XB_TMO])) break; if (sp > XB_SPIN_CAP) { atomicAdd(&bar[XB_TMO], 1u); break; } }
    }
    nloc = mine > 0u ? mine : 1u; nx = cnt > 0u ? cnt : 1u;
}
__device__ __forceinline__ void xcd_barrier(const XcdBarrier& b) {
    asm volatile("s_waitcnt vmcnt(0)" ::: "memory");
    __syncthreads();
    if (threadIdx.x == 0) {
        unsigned* bar = b.bar;
        __builtin_amdgcn_s_waitcnt(0);
        unsigned nloc = b.st[0], nx = b.st[1];
        if (nloc == 0u) { xcd_barrier_complete(bar, b.x, nloc, nx); b.st[0] = nloc; b.st[1] = nx; }
        const unsigned old = xb_add(&bar[XB_XSUB(b.x)], 1u);
        const unsigned gen = old / nloc;
        if (old + 1u == (gen + 1u) * nloc) {
            __builtin_amdgcn_fence(__ATOMIC_RELEASE, "agent");
            asm volatile("s_waitcnt vmcnt(0)" ::: "memory");
            const unsigned og = xb_add(&bar[XB_TOP], 1u);
            const unsigned tg = og / nx;
            if (og + 1u == (tg + 1u) * nx) xb_add(&bar[XB_TOPGEN], 1u);
            else XB_SPIN(xb_ld(&bar[XB_TOPGEN]) == tg, bar);
            __builtin_amdgcn_fence(__ATOMIC_ACQUIRE, "agent");
            xb_add(&bar[XB_XGEN(b.x)], 1u);
            asm volatile("s_waitcnt vmcnt(0)" ::: "memory");
        } else {
            XB_SPIN(xb_ld(&bar[XB_XGEN(b.x)]) == gen, bar);
            __builtin_amdgcn_fence(__ATOMIC_ACQUIRE, "agent");
            asm volatile("s_waitcnt vmcnt(0)" ::: "memory");
        }
    }
    __syncthreads();
}

#define PHASE_VARS const int tid = launder_v((int)threadIdx.x), lane = tid & 63, wave = __builtin_amdgcn_readfirstlane(tid >> 6); (void)lane; (void)wave; \
    Args a = a_; a.ws = launder_p(a_.ws); a.out = launder_p(a_.out); unsigned char* ws = a.ws; (void)ws; \
    const int G = gridDim.x, bid = blockIdx.x; const int gtid = bid * NTHR + tid, NGT = G * NTHR; (void)gtid; (void)NGT; \
    float* ssq = (float*)(ws + WS_SSQ); bf16* xb = (bf16*)(ws + WS_XB); (void)ssq; (void)xb; \
    unsigned char* wt = ws + WS_WT + (size_t)layer * WT_LAYER; (void)wt;
__global__ void __launch_bounds__(NTHR, 2) hybrid_fwd(Args a_) {
    extern __shared__ __attribute__((aligned(16))) unsigned char lds[];
    cg::grid_group grid = cg::this_grid();
    PG8_LAS unsigned char* ldsl = (PG8_LAS unsigned char*)lds;
#ifndef NO_PRO
    for (int rep = 0; rep < REP_PRO; ++rep) { const int layer = 0; PHASE_VARS; prologue(a, lds, tid, lane, wave, G); weight_jobs(a, lds, 0, 0, I_IN, bid * NWAVES + wave, G * NWAVES, lane, wave); __syncthreads(); }
#endif
    if (threadIdx.x < 2) ((volatile LAS unsigned*)(ldsl + 143376))[threadIdx.x] = 0u;
    grid.sync();
    const XcdBarrier xbar = xcd_barrier_post((unsigned*)(a_.ws + WS_BAR), (volatile LAS unsigned*)(ldsl + 143376));
#pragma unroll 1
    for (int layer = 0; layer < 2; ++layer) {
#ifndef NO_G1
        for (int rep = 0; rep < REP_G17; ++rep) {   PHASE_VARS; pg8::Gemm g{xb, (const bf16*)(wt + WT_IN), D, D, D}; pg8::StaticOrder S; S.init(M, NIN, G, bid);
            pg8::EpiInProj E{(float*)(ws + WS_PROJM), (bf16*)(ws + WS_GATES), (bf16*)(ws + WS_ABF), (const float*)(ws + WS_ROPE), ssq + (size_t)(2 * layer) * M};
            pg8::gemm_phase(ldsl, g, S, E);
            if (rep == 0) { const int nb = (M / 256) * (NIN / 256) % G; const int nidle = nb ? G - nb : G; const int me = nb ? bid - nb : bid;
                constexpr int DN0 = I_IN + 4 * I_BR + I_OUT + I_GU, DN1 = DN0 + I_DN;
                if (me >= 0) {
#pragma unroll 1
                    for (int seg = 0; seg < 3; ++seg) { const int wl = seg == 2 ? 1 : layer; const int lo = seg == 0 ? I_IN : seg == 1 ? DN1 : 0;
                        const int hi = seg == 0 ? (layer == 0 ? DN1 : DN0) : seg == 1 ? I_LAYER : (layer == 0 ? IN1_EARLY : 0);
                        weight_jobs(a, lds, wl, lo, hi, me * NWAVES + wave, nidle * NWAVES, lane, wave); } } }
            if (REP_G17 > 1) __syncthreads(); }
#endif
        GSYNC();
        for (int rep = 0; rep < REP_MIX; ++rep) {
        for (int r2 = 0; r2 < REP_P2; ++r2) {
#ifndef NO_GLA1
        for (int q3 = 0; q3 < REP_G1; ++q3) {   PHASE_VARS; for (int u = bid; u < 512; u += G) gla_g1(a, layer, u, lds, tid, lane, wave); }
#endif
#ifndef NO_S51
        {   PHASE_VARS; for (int u = bid; u < 256; u += G) s5_s1(a, layer, u, lds, tid, lane, wave); }
#endif
        }
        GSYNC();
#ifndef NO_SCAN
        {   PHASE_VARS; if (gtid < 65536) gla_g2(a, gtid); else if (gtid < 65536 + 4096) s5_s2(a, layer, gtid - 65536); }
#endif
#ifndef NO_ATT
        for (int r3 = 0; r3 < REP_P3; ++r3)
        {   PHASE_VARS; unsigned* cnt = (unsigned*)(ws + WS_CNT) + layer * 8 + rep * 4 + r3;
            attn_phase(a, layer, cnt, lds, tid, lane, wave); __syncthreads(); }
#endif
        GSYNC();
        for (int r4 = 0; r4 < REP_P4; ++r4) {
#ifndef NO_S53
        for (int q3 = 0; q3 < REP_S3; ++q3) {   PHASE_VARS; for (int u = bid; u < 256; u += G) s5_s3(a, layer, u, lds, tid, lane, wave); }
#endif
#ifndef NO_GLA3
        for (int q3 = 0; q3 < REP_G3; ++q3) {   PHASE_VARS; g3_phase(a, layer, lds, tid, lane, wave, bid, G); __syncthreads(); }
#endif
        {   PHASE_VARS; dil_merge(a, gtid, NGT); }
        }
        GSYNC();
        }
#ifndef NO_G5
        for (int q5 = 0; q5 < REP_G5; ++q5) {   PHASE_VARS; pg8::Gemm g{(const bf16*)(ws + WS_BR), (const bf16*)(wt + WT_BR), D, D, 512}; pg8::BranchOrder S{G, bid};
            pg8::EpiBranch E{(const bf16*)(ws + WS_GATES), (bf16*)(ws + WS_MIXB)};
            pg8::gemm_phase(ldsl, g, S, E); }
#endif
        GSYNC();
#ifndef NO_G6
        {   PHASE_VARS; pg8::Gemm g{(const bf16*)(ws + WS_MIXB), (const bf16*)(wt + WT_OUT), D, D, D}; pg8::StaticOrder S; S.init(M, D, G, bid);
            pg8::EpiResid E{layer == 0 ? a.in[0] : a.out, a.out, xb, ssq + (size_t)(2 * layer + 1) * M};
            pg8::gemm_phase(ldsl, g, S, E); }
#endif
        GSYNC();
#ifndef NO_G7
        for (int rep = 0; rep < REP_G17; ++rep) {   PHASE_VARS; pg8::Gemm g{xb, (const bf16*)(wt + WT_GU), D, D, D}; pg8::StaticOrder S; S.init(M, NGU, G, bid);
            pg8::EpiGateUp E{(bf16*)(ws + WS_HID), ssq + (size_t)(2 * layer + 1) * M};
            pg8::gemm_phase(ldsl, g, S, E);
            if (rep == 0) { const int nb = (M / 256) * (NGU / 256) % G; const int nidle = nb ? G - nb : G; const int me = nb ? bid - nb : bid;
                constexpr int DN0 = I_IN + 4 * I_BR + I_OUT + I_GU, DN1 = DN0 + I_DN;
                if (me >= 0) weight_jobs(a, lds, 1, layer == 0 ? IN1_EARLY : DN0, layer == 0 ? I_IN : DN1, me * NWAVES + wave, nidle * NWAVES, lane, wave); }
            if (REP_G17 > 1) __syncthreads(); }
#endif
        GSYNC();
#ifndef NO_G8
        {   PHASE_VARS; pg8::Gemm g{(const bf16*)(ws + WS_HID), (const bf16*)(wt + WT_DN), FF, FF, FF}; pg8::StaticOrder S; S.init(M, D, G, bid);
            pg8::EpiResid E{a.out, a.out, xb, ssq + (size_t)(2 * layer + 2) * M};
            pg8::gemm_phase(ldsl, g, S, E); }
#endif
        GSYNC();
    }
    {   const int layer = 0; PHASE_VARS; const float* gF = a.in[24]; const int gw = bid * NWAVES + wave, NGW = G * NWAVES;
        for (int row = gw; row < M; row += NGW) {
            const float rstd = rsqrtf(ssq[4 * M + row] * (1.0f / 2048.0f) + 1e-6f);
            f32x4* xr = (f32x4*)(a.out + (size_t)row * D) + lane; const f32x4* gp = (const f32x4*)gF + lane;
#pragma unroll
            for (int j = 0; j < 8; ++j) { f32x4 v = xr[64 * j]; const f32x4 g4 = gp[64 * j]; v = v * rstd * g4; xr[64 * j] = v; }
        }
    }
}

extern "C" void kernel_launch(void* const* d_in, const int* in_sizes, int n_in, void* d_out, int out_size, void* d_ws, size_t ws_size, hipStream_t stream) {
    static int grid = 0;
    if (grid == 0) {
        if (n_in != 25 || out_size != M * D || ws_size < WS_END) { fprintf(stderr, "kernel_launch: unexpected shapes (n_in %d, out %d, ws %zu < %zu)\n", n_in, out_size, ws_size, (size_t)WS_END); grid = -1; return; }
        int dev = 0, cus = 0, per_cu = 0;
        (void)hipGetDevice(&dev); (void)hipDeviceGetAttribute(&cus, hipDeviceAttributeMultiprocessorCount, dev);
        if (hipFuncSetAttribute((const void*)hybrid_fwd, hipFuncAttributeMaxDynamicSharedMemorySize, LDS_BYTES) != hipSuccess) { fprintf(stderr, "kernel_launch: hipFuncSetAttribute failed\n"); grid = -1; return; }
        if (hipOccupancyMaxActiveBlocksPerMultiprocessor(&per_cu, (const void*)hybrid_fwd, NTHR, LDS_BYTES) != hipSuccess || per_cu < 1) { fprintf(stderr, "kernel_launch: occupancy query says %d\n", per_cu); per_cu = 1; }
        (void)hipGetLastError();
        grid = cus * per_cu;
    }
    if (grid < 0) return;
    Args a{};
    for (int i = 0; i < 25; ++i) a.in[i] = (const float*)d_in[i];
    a.out = (float*)d_out; a.ws = (unsigned char*)d_ws;
    void* args[] = {&a};
    hipError_t e = hipLaunchCooperativeKernel((const void*)hybrid_fwd, dim3(grid), dim3(NTHR), args, LDS_BYTES, stream);
    if (e != hipSuccess) fprintf(stderr, "cooperative launch failed: %s (grid %d)\n", hipGetErrorString(e), grid);
}
```

```cpp
#include <hip/hip_runtime.h>
#include <hip/hip_cooperative_groups.h>
#include <cstdio>
#include <cstdint>
namespace cg = cooperative_groups;
#ifndef REP_PRO
#define REP_PRO 1
#endif
#ifndef REP_MIX
#define REP_MIX 1
#endif
#ifndef REP_G17
#define REP_G17 1
#endif
#ifndef REP_P2
#define REP_P2 1
#endif
#ifndef REP_P3
#define REP_P3 1
#endif
#ifndef REP_P4
#define REP_P4 1
#endif
#ifndef REP_S3
#define REP_S3 1
#endif
#ifndef REP_G3
#define REP_G3 1
#endif
#ifndef REP_G1
#define REP_G1 1
#endif
#ifndef REP_G5
#define REP_G5 1
#endif
#ifndef REP_SYNC
#define REP_SYNC 1
#endif
#define GSYNC() do { for (int rs_ = 0; rs_ < REP_SYNC; ++rs_) xcd_barrier(xbar); } while (0)

namespace pg8 {
#define PG8_LAS __attribute__((address_space(3)))
typedef unsigned short bf16_t;
typedef short bf16x8 __attribute__((ext_vector_type(8)));
typedef float f32x4 __attribute__((ext_vector_type(4)));
typedef unsigned u32x4 __attribute__((ext_vector_type(4)));
typedef unsigned u32x2 __attribute__((ext_vector_type(2)));
constexpr int BM = 256, BK = 64, HALF = 128, HTB = HALF * BK * 2, STAGE_BYTES = 8 * HTB, NXCD = 8, WGM = 2;

__host__ __device__ __forceinline__ int lds_byte(int r, int c) { const int st = (r >> 4) * 2 + (c >> 5), rr = r & 15, cc = c & 31, ob = rr * 64 + cc * 2; return st * 1024 + (ob ^ (((ob >> 9) & 1) << 5)); }
__host__ __device__ __forceinline__ void stage_rc(int b, int& R, int& C) { const int st = b / 1024, sb = b % 1024, swz = sb ^ (((sb >> 9) & 1) << 5); R = (st >> 1) * 16 + swz / 64; C = (st & 1) * 32 + (swz % 64) / 2; }
__host__ __device__ __forceinline__ int perm32(int rho) { const int n = rho >> 4, i = rho & 15; return 8 * (i >> 2) + 4 * n + (i & 3); }

struct Unit { int pm, pn, kz; };
struct Gemm { const bf16_t* A; const bf16_t* Bt; int lda, ldb, K; };

struct StaticOrder {
    int nM, nN, nwg, G, c;
    __host__ __device__ void init(int M, int N, int G_, int c_) { nM = M / BM; nN = N / BM; nwg = nM * nN; G = G_; c = c_; }
    __host__ __device__ bool next(int i, Unit& u) const {
        const long L = (long)i * G + c; if (L >= nwg) return false;
        int wgid = (int)L; { const int q = nwg / NXCD, r = nwg % NXCD, xcd = wgid % NXCD, off = wgid / NXCD; wgid = (xcd < r ? xcd * (q + 1) : r * (q + 1) + (xcd - r) * q) + off; }
        const int nig = WGM * nN, gid = wgid / nig, fm = gid * WGM, gsz = (nM - fm) < WGM ? (nM - fm) : WGM;
        u.pm = fm + ((wgid % nig) % gsz); u.pn = (wgid % nig) / gsz; u.kz = 0; return true;
    }
};
struct BranchOrder {
    int G, c;
    __host__ __device__ bool next(int i, Unit& u) const {
        const int tile = c + (i >> 2) * G; if (tile >= 256) return false;
        const int x = tile & 7, idx = tile >> 3;
        u.pm = 4 * x + (idx >> 3); u.pn = idx & 7; u.kz = i & 3; return true;
    }
};

__device__ __forceinline__ unsigned cvt_pk_bf16(float lo, float hi) { unsigned r; asm volatile("v_cvt_pk_bf16_f32 %0, %1, %2" : "=v"(r) : "v"(lo), "v"(hi)); return r; }
__device__ __forceinline__ float fsigmoid(float x) { return __frcp_rn(1.0f + __expf(-x)); }

struct EpiInProj {
    static constexpr bool PERM = true, CHAIN = false;
    float* projm; bf16_t* gates; bf16_t* abf; const float* rope; const float* ssq;
    __device__ __forceinline__ void operator()(f32x4 (&acc)[2][2][4][2], const Unit& u, int wr, int wc, int fr, int fq) const {
        const int row0 = u.pm * BM + wr * 64 + fr; const int colt = u.pn * BM; const int cw = wc * 32 + 8 * fq;
        const bool attn_tile = (colt >= 2048) && (colt < 4352);
        float rstd[2][4];
#pragma unroll
        for (int ai = 0; ai < 2; ++ai)
#pragma unroll
            for (int m = 0; m < 4; ++m) rstd[ai][m] = ssq[row0 + ai * HALF + m * 16];
#pragma unroll
        for (int ai = 0; ai < 2; ++ai)
#pragma unroll
            for (int m = 0; m < 4; ++m) rstd[ai][m] = rsqrtf(rstd[ai][m] * (1.0f / 2048.0f) + 1e-6f);
        if (attn_tile) {
            const bool rotw = (wc & 1) == 0;
#pragma unroll
            for (int aim = 0; aim < 4; ++aim) { const int ai = aim >> 1, mb = (aim & 1) * 2;
                f32x4 rp[4][4];
                if (rotw) {
#pragma unroll
                    for (int m = mb; m < mb + 2; ++m) { const float* rr = rope + (size_t)(row0 + ai * HALF + m * 16) * 16;
#pragma unroll
                        for (int q = 0; q < 4; ++q) rp[m][q] = *(const f32x4*)(rr + 4 * q); }
                }
#pragma unroll
                for (int m = mb; m < mb + 2; ++m) {
                    const int row = row0 + ai * HALF + m * 16;
#pragma unroll
                    for (int bj = 0; bj < 2; ++bj) {
                        f32x4 v0 = acc[ai][bj][m][0] * rstd[ai][m], v1 = acc[ai][bj][m][1] * rstd[ai][m];
                        const int cb = colt + bj * HALF;
                        const bool isrot = (cb < 3072) || (cb >= 3584 && cb < 4224);
                        const bool isq = (cb < 2560) || (cb >= 3584 && cb < 4096);
                        if (isrot && rotw) {
#pragma unroll
                            for (int j = 0; j < 4; ++j) { const float p0 = __shfl_xor(v0[j], 16), p1 = __shfl_xor(v1[j], 16);
                                if (fq == 0) { v0[j] = v0[j] * rp[m][0][j] - p0 * rp[m][2][j]; v1[j] = v1[j] * rp[m][1][j] - p1 * rp[m][3][j]; }
                                else if (fq == 1) { v0[j] = v0[j] * rp[m][0][j] + p0 * rp[m][2][j]; v1[j] = v1[j] * rp[m][1][j] + p1 * rp[m][3][j]; } }
                        }
                        if (isq) { v0 = v0 * 0.125f; v1 = v1 * 0.125f; }
                        u32x4 w; w.x = cvt_pk_bf16(v0[0], v0[1]); w.y = cvt_pk_bf16(v0[2], v0[3]); w.z = cvt_pk_bf16(v1[0], v1[1]); w.w = cvt_pk_bf16(v1[2], v1[3]);
                        __builtin_nontemporal_store(w, (u32x4*)(abf + (size_t)row * 2304 + (cb + cw - 2048)));
                    }
                }
            }
            return;
        }
#pragma unroll
        for (int ai = 0; ai < 2; ++ai)
#pragma unroll
            for (int m = 0; m < 4; ++m) {
                const int row = row0 + ai * HALF + m * 16;
#pragma unroll
                for (int bj = 0; bj < 2; ++bj) {
                    f32x4 v0 = acc[ai][bj][m][0] * rstd[ai][m], v1 = acc[ai][bj][m][1] * rstd[ai][m];
                    const int col = colt + bj * HALF + cw;
                    if (colt < 4608) {
                        float* p = projm + (size_t)row * 4608 + col;
                        __builtin_nontemporal_store(v0, (f32x4*)p); __builtin_nontemporal_store(v1, (f32x4*)(p + 4));
                    } else {
                        u32x4 w; w.x = cvt_pk_bf16(fsigmoid(v0[0]), fsigmoid(v0[1])); w.y = cvt_pk_bf16(fsigmoid(v0[2]), fsigmoid(v0[3]));
                        w.z = cvt_pk_bf16(fsigmoid(v1[0]), fsigmoid(v1[1])); w.w = cvt_pk_bf16(fsigmoid(v1[2]), fsigmoid(v1[3]));
                        __builtin_nontemporal_store(w, (u32x4*)(gates + (size_t)row * 8192 + (col - 4608)));
                    }
                }
            }
    }
};
__device__ __forceinline__ float bf_lo(unsigned w) { return __uint_as_float(w << 16); }
__device__ __forceinline__ float bf_hi(unsigned w) { return __uint_as_float(w & 0xffff0000u); }
struct EpiBranch {
    static constexpr bool PERM = true, CHAIN = true;
    const bf16_t* gates; bf16_t* mixb;
    __device__ __forceinline__ void operator()(f32x4 (&acc)[2][2][4][2], const Unit& u, int wr, int wc, int fr, int fq) const {
        const int row0 = u.pm * BM + wr * 64 + fr; const int col0 = u.pn * BM + wc * 32 + 8 * fq;
#pragma unroll
        for (int aim = 0; aim < 4; ++aim) { const int ai = aim >> 1, mb = (aim & 1) * 2;
            u32x4 g[4][2], hn[4][2];
#pragma unroll
            for (int m = mb; m < mb + 2; ++m)
#pragma unroll
                for (int bj = 0; bj < 2; ++bj) { const bf16_t* gp = gates + (size_t)(row0 + ai * HALF + m * 16) * 8192 + u.kz * 2048 + col0 + bj * HALF;
                    g[m][bj] = *(const u32x4*)gp; hn[m][bj] = (u.kz < 3) ? *(const u32x4*)(gp + 2048) : (u32x4){0u, 0u, 0u, 0u}; }
#pragma unroll
            for (int m = mb; m < mb + 2; ++m) {
                const int row = row0 + ai * HALF + m * 16;
#pragma unroll
                for (int bj = 0; bj < 2; ++bj) {
                    const int col = col0 + bj * HALF;
                    const u32x4 gg = g[m][bj], h = hn[m][bj];
                    float sc[8] = {bf_lo(gg.x), bf_hi(gg.x), bf_lo(gg.y), bf_hi(gg.y), bf_lo(gg.z), bf_hi(gg.z), bf_lo(gg.w), bf_hi(gg.w)};
                    if (u.kz < 3) {
                        const float dn[8] = {bf_lo(h.x), bf_hi(h.x), bf_lo(h.y), bf_hi(h.y), bf_lo(h.z), bf_hi(h.z), bf_lo(h.w), bf_hi(h.w)};
#pragma unroll
                        for (int j = 0; j < 8; ++j) sc[j] *= __frcp_rn(fmaxf(dn[j], 1e-30f)); }
                    f32x4 v0 = acc[ai][bj][m][0], v1 = acc[ai][bj][m][1];
#pragma unroll
                    for (int j = 0; j < 4; ++j) { v0[j] *= sc[j]; v1[j] *= sc[4 + j]; }
                    acc[ai][bj][m][0] = v0; acc[ai][bj][m][1] = v1;
                    if (u.kz == 3) { u32x4 w; w.x = cvt_pk_bf16(v0[0], v0[1]); w.y = cvt_pk_bf16(v0[2], v0[3]); w.z = cvt_pk_bf16(v1[0], v1[1]); w.w = cvt_pk_bf16(v1[2], v1[3]);
                        *(u32x4*)(mixb + (size_t)row * 2048 + col) = w; }
                }
            }
        }
    }
};
struct EpiResid {
    static constexpr bool PERM = true, CHAIN = false;
    const float* resid; float* out; bf16_t* xb; float* ssq;
    __device__ __forceinline__ void operator()(f32x4 (&acc)[2][2][4][2], const Unit& u, int wr, int wc, int fr, int fq) const {
        const int row0 = u.pm * BM + wr * 64 + fr; const int col0 = u.pn * BM + wc * 32 + 8 * fq;
#pragma unroll
        for (int aim = 0; aim < 2; ++aim) { const int ai = aim, mb = 0;
            f32x4 rv[4][2][2];
#pragma unroll
            for (int m = mb; m < mb + 4; ++m)
#pragma unroll
                for (int bj = 0; bj < 2; ++bj) { const float* rp = resid + (size_t)(row0 + ai * HALF + m * 16) * 2048 + col0 + bj * HALF; rv[m][bj][0] = *(const f32x4*)rp; rv[m][bj][1] = *(const f32x4*)(rp + 4); }
#pragma unroll
            for (int m = mb; m < mb + 4; ++m) {
                const int row = row0 + ai * HALF + m * 16; float s = 0.f;
#pragma unroll
                for (int bj = 0; bj < 2; ++bj) {
                    const size_t off = (size_t)row * 2048 + col0 + bj * HALF;
                    const f32x4 v0 = rv[m][bj][0] + acc[ai][bj][m][0], v1 = rv[m][bj][1] + acc[ai][bj][m][1];
                    *(f32x4*)(out + off) = v0; *(f32x4*)(out + off + 4) = v1;
                    u32x4 w; w.x = cvt_pk_bf16(v0[0], v0[1]); w.y = cvt_pk_bf16(v0[2], v0[3]); w.z = cvt_pk_bf16(v1[0], v1[1]); w.w = cvt_pk_bf16(v1[2], v1[3]);
                    *(u32x4*)(xb + off) = w;
                    s += (v0[0] * v0[0] + v0[1] * v0[1]) + (v0[2] * v0[2] + v0[3] * v0[3]) + (v1[0] * v1[0] + v1[1] * v1[1]) + (v1[2] * v1[2] + v1[3] * v1[3]);
                }
                s += __shfl_xor(s, 16); s += __shfl_xor(s, 32);
                if (fq == 0) atomicAdd(ssq + row, s);
            }
        }
    }
};
struct EpiGateUp {
    static constexpr bool PERM = true, CHAIN = false;
    bf16_t* hid; const float* ssq;
    __device__ __forceinline__ void operator()(f32x4 (&acc)[2][2][4][2], const Unit& u, int wr, int wc, int fr, int fq) const {
        const int row0 = u.pm * BM + wr * 64 + fr; const int col0 = u.pn * HALF + wc * 32 + 8 * fq;
        float rs[2][4];
#pragma unroll
        for (int ai = 0; ai < 2; ++ai)
#pragma unroll
            for (int m = 0; m < 4; ++m) rs[ai][m] = ssq[row0 + ai * HALF + m * 16];
#pragma unroll
        for (int ai = 0; ai < 2; ++ai)
#pragma unroll
            for (int m = 0; m < 4; ++m) {
                const int row = row0 + ai * HALF + m * 16;
                const float rstd = rsqrtf(rs[ai][m] * (1.0f / 2048.0f) + 1e-6f);
                float o[8];
#pragma unroll
                for (int n = 0; n < 2; ++n)
#pragma unroll
                    for (int j = 0; j < 4; ++j) { const float g = acc[ai][0][m][n][j] * rstd, up = acc[ai][1][m][n][j] * rstd; o[n * 4 + j] = g * fsigmoid(g) * up; }
                u32x4 w; w.x = cvt_pk_bf16(o[0], o[1]); w.y = cvt_pk_bf16(o[2], o[3]); w.z = cvt_pk_bf16(o[4], o[5]); w.w = cvt_pk_bf16(o[6], o[7]);
                __builtin_nontemporal_store(w, (u32x4*)(hid + (size_t)row * 5632 + col0));
            }
    }
};

template <class Epi, class Sched>
__device__ __forceinline__ void gemm_phase(PG8_LAS unsigned char* lds, const Gemm g, const Sched& S, const Epi& E) {
    int tid_ = threadIdx.x; asm volatile("" : "+v"(tid_));
    const int tid = tid_, wid = __builtin_amdgcn_readfirstlane(tid >> 6), lane = tid & 63, wr = wid >> 2, wc = wid & 3, fr = lane & 15, fq = lane >> 4;
    const int K = g.K, nt = K / BK;
    unsigned voffA[2], voffB[2];
#pragma unroll
    for (int i = 0; i < 2; ++i) { int R, C; stage_rc(tid * 16 + i * 8192, R, C); const int Rb = Epi::PERM ? ((R & ~31) + perm32(R & 31)) : R;
        voffA[i] = (unsigned)(R * g.lda + C) * 2u; voffB[i] = (unsigned)(Rb * g.ldb + C) * 2u; }
    const size_t kstep = (size_t)(BK * 2);
    const size_t hstepA = (size_t)HALF * g.lda * 2, hstepB = (size_t)HALF * g.ldb * 2;
    const size_t tstepA = 2 * hstepA, tstepB = 2 * hstepB;
    const unsigned ldsw = (unsigned)wid * 1024u;
    const int aoff = lds_byte(wr * 64 + fr, fq * 8), boff = lds_byte(wc * 32 + fr, fq * 8);
#define PG8_SA(b, h) (((b) * 2 + (h)) * HTB)
#define PG8_SB(b, h) ((4 + (b) * 2 + (h)) * HTB)
#define PG8_STAGE(bufoff, gbase, voff) do { _Pragma("unroll") for (int _i = 0; _i < 2; ++_i) \
        __builtin_amdgcn_global_load_lds((const unsigned*)((const char*)(gbase) + (voff)[_i]), (PG8_LAS unsigned*)(lds + (bufoff) + ldsw + _i * 8192), 16, 0, 0); } while (0)
#define PG8_LDA(dst, b, h) do { _Pragma("unroll") for (int m = 0; m < 4; ++m) _Pragma("unroll") for (int k = 0; k < 2; ++k) dst[m][k] = *(const PG8_LAS bf16x8*)(lds + PG8_SA(b, h) + aoff + m * 2048 + k * 1024); } while (0)
#define PG8_LDB(dst, b, h) do { _Pragma("unroll") for (int n = 0; n < 2; ++n) _Pragma("unroll") for (int k = 0; k < 2; ++k) dst[n][k] = *(const PG8_LAS bf16x8*)(lds + PG8_SB(b, h) + boff + n * 2048 + k * 1024); } while (0)
#define PG8_MMA(ai, bj, At, Bt) do { __builtin_amdgcn_s_setprio(1); _Pragma("unroll") for (int m = 0; m < 4; ++m) _Pragma("unroll") for (int n = 0; n < 2; ++n) _Pragma("unroll") for (int k = 0; k < 2; ++k) \
        acc[ai][bj][m][n] = __builtin_amdgcn_mfma_f32_16x16x32_bf16(Bt[n][k], At[m][k], acc[ai][bj][m][n], 0, 0, 0); __builtin_amdgcn_s_setprio(0); } while (0)
#define PG8_WAIT_V(n) asm volatile("s_waitcnt vmcnt(" #n ")" ::: "memory")
#define PG8_WAIT_L(n) asm volatile("s_waitcnt lgkmcnt(" #n ")" ::: "memory")
#define PG8_BAR __builtin_amdgcn_s_barrier()
#define PG8_SCHED __builtin_amdgcn_sched_barrier(0)
    Unit cur, nxt; int ui = 0;
    if (!S.next(0, cur)) return;
    f32x4 acc[2][2][4][2];
#pragma unroll
    for (int a = 0; a < 2; ++a)
#pragma unroll
        for (int b = 0; b < 2; ++b)
#pragma unroll
            for (int m = 0; m < 4; ++m)
#pragma unroll
                for (int n = 0; n < 2; ++n) acc[a][b][m][n] = (f32x4){0.f, 0.f, 0.f, 0.f};
    bf16x8 At[4][2], B0[2][2], B1[2][2];
    const char* cA = (const char*)g.A + (size_t)cur.pm * tstepA + (size_t)cur.kz * K * 2; const char* cB = (const char*)g.Bt + (size_t)cur.pn * tstepB + (size_t)cur.kz * K * 2;
    PG8_STAGE(PG8_SB(0, 0), cB, voffB); PG8_STAGE(PG8_SB(0, 1), cB + hstepB, voffB); PG8_STAGE(PG8_SA(0, 0), cA, voffA); PG8_STAGE(PG8_SA(0, 1), cA + hstepA, voffA);
    if (wr == 1) PG8_BAR;
    PG8_WAIT_V(2); PG8_BAR;
    PG8_STAGE(PG8_SB(1, 0), cB + kstep, voffB); PG8_STAGE(PG8_SA(1, 0), cA + kstep, voffA); PG8_STAGE(PG8_SB(1, 1), cB + hstepB + kstep, voffB);
    PG8_WAIT_V(6); PG8_BAR;
    for (;;) {
        const bool has_next = S.next(ui + 1, nxt);
        const char* nA = has_next ? (const char*)g.A + (size_t)nxt.pm * tstepA + (size_t)nxt.kz * K * 2 : cA;
        const char* nB = has_next ? (const char*)g.Bt + (size_t)nxt.pn * tstepB + (size_t)nxt.kz * K * 2 : cB;
        for (int t = 0; t < nt; t += 2) {
            const bool last = (t == nt - 2);
            const char* a1 = cA + (size_t)(t + 1) * kstep;
            const char* a2 = last ? nA : cA + (size_t)(t + 2) * kstep; const char* b2 = last ? nB : cB + (size_t)(t + 2) * kstep;
            const char* a3 = a2 + kstep; const char* b3 = b2 + kstep;
            PG8_LDB(B0, 0, 0); PG8_LDB(B1, 0, 1); PG8_SCHED; PG8_LDA(At, 0, 0); PG8_STAGE(PG8_SA(1, 1), a1 + hstepA, voffA);
            PG8_WAIT_V(8); PG8_WAIT_L(0); PG8_BAR; PG8_MMA(0, 0, At, B0); PG8_MMA(0, 1, At, B1); PG8_BAR; PG8_SCHED;
            PG8_LDA(At, 0, 1); PG8_STAGE(PG8_SB(0, 0), b2, voffB); PG8_STAGE(PG8_SB(0, 1), b2 + hstepB, voffB); PG8_STAGE(PG8_SA(0, 0), a2, voffA);
            PG8_WAIT_V(8); PG8_WAIT_L(0); PG8_BAR; PG8_MMA(1, 0, At, B0); PG8_MMA(1, 1, At, B1); PG8_BAR; PG8_SCHED;
            PG8_LDB(B0, 1, 0); PG8_LDB(B1, 1, 1); PG8_SCHED; PG8_LDA(At, 1, 0); PG8_STAGE(PG8_SA(0, 1), a2 + hstepA, voffA);
            PG8_WAIT_V(8); PG8_WAIT_L(0); PG8_BAR; PG8_MMA(0, 0, At, B0); PG8_MMA(0, 1, At, B1); PG8_BAR; PG8_SCHED;
            PG8_LDA(At, 1, 1); PG8_STAGE(PG8_SB(1, 0), b3, voffB); PG8_STAGE(PG8_SB(1, 1), b3 + hstepB, voffB); PG8_STAGE(PG8_SA(1, 0), a3, voffA);
            PG8_WAIT_V(8); PG8_WAIT_L(0); PG8_BAR; PG8_MMA(1, 0, At, B0); PG8_MMA(1, 1, At, B1); PG8_BAR; PG8_SCHED;
        }
        if (wr == 0) PG8_BAR;
        E(acc, cur, wr, wc, fr, fq);
        if (!has_next) break;
        if (!(Epi::CHAIN && nxt.kz != 0)) {
#pragma unroll
        for (int a = 0; a < 2; ++a)
#pragma unroll
            for (int b = 0; b < 2; ++b)
#pragma unroll
                for (int m = 0; m < 4; ++m)
#pragma unroll
                    for (int n = 0; n < 2; ++n) acc[a][b][m][n] = (f32x4){0.f, 0.f, 0.f, 0.f};
        }
        cur = nxt; cA = nA; cB = nB; ++ui;
        if (wr == 1) PG8_BAR;
    }
    PG8_WAIT_V(0);
    PG8_BAR;
#undef PG8_SA
#undef PG8_SB
#undef PG8_STAGE
#undef PG8_LDA
#undef PG8_LDB
#undef PG8_MMA
#undef PG8_WAIT_V
#undef PG8_WAIT_L
#undef PG8_BAR
#undef PG8_SCHED
}
}

typedef unsigned short bf16;
typedef float f32x4 __attribute__((ext_vector_type(4)));
typedef short bf16x8 __attribute__((ext_vector_type(8)));
typedef short s16x4 __attribute__((ext_vector_type(4)));
typedef unsigned v4u __attribute__((ext_vector_type(4)));
typedef unsigned v2u __attribute__((ext_vector_type(2)));
constexpr int NWAVES = 8, NTHR = 512;
constexpr int SEQ = 4096, M = 8192, D = 2048, DIN = 12560, NMIX = 4608, NIN = 12800, FF = 5632, NGU = 11264;
constexpr int C_GQ = 0, C_GK = 256, C_GV = 512, C_GR = 1024, C_S5 = 1536, C_CQ = 2048, C_CK = 2560, C_CV = 3072, C_SQ = 3584, C_SK = 4096, C_SV = 4224, C_LR = 4352;
__host__ __device__ __forceinline__ int orig_col(int c) { return c < 1536 ? c : c < 4352 ? c + 16 : c < 4368 ? c - 4352 + 1536 : c < 4608 ? -1 : c - 240; }

constexpr size_t MiB = 1u << 20;
constexpr size_t WS_SSQ = 0, WS_CNT = 512 * 1024, WS_BAR = 768 * 1024, WS_S5A = 1536 * 1024, WS_S5B = 1600 * 1024, WS_ROPE = 1 * MiB, WS_GLAST = 2 * MiB, WS_GLU = 3 * MiB, WS_WT = 4 * MiB, WT_LAYER = 132 * MiB;
constexpr size_t WT_IN = 0, WT_BR = 50 * MiB, WT_OUT = 58 * MiB, WT_GU = 66 * MiB, WT_DN = 110 * MiB;
constexpr size_t WS_XB = 268 * MiB, WS_PROJM = 300 * MiB, WS_MIXF = 300 * MiB, WS_MIXB = 364 * MiB, WS_GATES = 444 * MiB, WS_HID = 444 * MiB, WS_BR = 572 * MiB;
constexpr size_t WS_GKV = 604 * MiB, WS_GST = 620 * MiB, WS_S5E = 636 * MiB, WS_S5C = 640 * MiB, WS_OPART = 644 * MiB, WS_ML = 692 * MiB, WS_ABF = 694 * MiB, WS_GCUM = 730 * MiB, WS_END = 738 * MiB;
constexpr int LDS_BYTES = 147456;
#define XCD_BAR_WORDS 3456

struct Args { const float* in[25]; float* out; unsigned char* ws; };

__device__ __forceinline__ unsigned f2bf(float f) { unsigned u = __float_as_uint(f); return (u + 0x7fffu + ((u >> 16) & 1u)) >> 16; }
__device__ __forceinline__ unsigned pk2(float lo, float hi) { return f2bf(lo) | (f2bf(hi) << 16); }
__device__ __forceinline__ float wave_sum(float v) {
#pragma unroll
    for (int o = 1; o < 64; o <<= 1) v += __shfl_xor(v, o);
    return v;
}
#define LDS_WAIT() asm volatile("s_waitcnt lgkmcnt(0)" ::: "memory")
__device__ __forceinline__ int launder_v(int x) { asm volatile("" : "+v"(x)); return x; }
template <class T> __device__ __forceinline__ T* launder_p(T* p) { asm volatile("" : "+s"(p)); return p; }

template <int MODE>
__device__ __forceinline__ void transpose_item(const float* w0, const float* w1, int ld_src, const float* scale, bf16* dst, int ld_dst, int koff, int nblk, float* scr, int item, int lane) {
    const int kb = item / nblk, nb = item % nblk, k0 = 64 * kb, n0 = 64 * nb;
    const int n_ = n0 + lane;
    const float* cp;
    if (MODE == 0) cp = w0 + n_;
    else if (MODE == 1) { const int oc = orig_col(n_); cp = w0 + (oc >= 0 ? oc : 0); }
    else cp = ((n_ & 255) < 128 ? w0 : w1) + (n_ >> 8) * 128 + (n_ & 127);
    const bool valid = (MODE != 1) || (orig_col(n_) >= 0);
    cp += (size_t)k0 * ld_src;
    float tv[64];
#pragma unroll
    for (int kk = 0; kk < 64; ++kk) tv[kk] = cp[(size_t)kk * ld_src];
#pragma unroll
    for (int kk = 0; kk < 64; ++kk) { float v = tv[kk]; if (!valid) v = 0.f; if (scale) v *= scale[k0 + kk]; scr[kk * 65 + lane] = v; }
    LDS_WAIT(); asm volatile("" ::: "memory");
    const int c = lane & 7;
#pragma unroll
    for (int j = 0; j < 8; ++j) { const int n = (lane >> 3) + 8 * j; const float* sp = scr + (8 * c) * 65 + n;
        v4u o; o.x = pk2(sp[0 * 65], sp[1 * 65]); o.y = pk2(sp[2 * 65], sp[3 * 65]); o.z = pk2(sp[4 * 65], sp[5 * 65]); o.w = pk2(sp[6 * 65], sp[7 * 65]);
        *(v4u*)(dst + (size_t)(n0 + n) * ld_dst + koff + k0 + 8 * c) = o; }
    LDS_WAIT(); asm volatile("" ::: "memory");
}

__device__ __forceinline__ void prologue(const Args& a, unsigned char* lds, int tid, int lane, int wave, int G) {
    unsigned char* ws = a.ws;
    const int gw = blockIdx.x * NWAVES + wave, NGW = G * NWAVES;
    const int gtid = blockIdx.x * NTHR + tid, NGT = G * NTHR;
    float* ssq = (float*)(ws + WS_SSQ);
    for (int i = gtid; i < 4 * M; i += NGT) ssq[M + i] = 0.f;
    if (gtid < 64) ((unsigned*)(ws + WS_CNT))[gtid] = 0u;
    if (gtid < XCD_BAR_WORDS) ((unsigned*)(ws + WS_BAR))[gtid] = 0u;
    { const int* pos = (const int*)a.in[1]; float* rope = (float*)(ws + WS_ROPE);
      for (int i = gtid; i < M * 8; i += NGT) { const int tok = i >> 3, f = i & 7;
          const double invf = f == 0 ? 1.0 : f == 1 ? 0.19392274474868576 : f == 2 ? 0.03760603093086393 : f == 3 ? 0.007292664737217109 : f == 4 ? 0.001414213562373095 : f == 5 ? 0.0002742481756762073 : f == 6 ? 5.318295896944988e-05 : 1.031338537721246e-05;
          const double ang = (double)pos[tok] * invf; const double kq = rint(ang * 0.15915494309189535); const float rr = (float)(ang - kq * 6.283185307179586);
          rope[tok * 16 + f] = cosf(rr); rope[tok * 16 + 8 + f] = sinf(rr); } }
    if (gtid < 4096) { const int n = gtid & 63, g = (gtid >> 6) & 31, l = gtid >> 11;
        const float dt = expf(a.in[9][l * 32 + g]);
        const float lr = a.in[7][(l * 32 + g) * 64 + n], li = a.in[8][(l * 32 + g) * 64 + n];
        const float mag = expf(lr * dt); const float ar = mag * cosf(li * dt), ai = mag * sinf(li * dt);
        float pr = ar, pi = ai;
#pragma unroll
        for (int i = 0; i < 5; ++i) { const float nr = pr * pr - pi * pi, ni = 2.0f * pr * pi; pr = nr; pi = ni; }
        *(f32x4*)((float*)(ws + WS_S5A) + (size_t)gtid * 4) = (f32x4){ar, ai, pr, pi};
        const float den = lr * lr + li * li;
        const float zr = ((ar - 1.0f) * lr + ai * li) / den, zi = (ai * lr - (ar - 1.0f) * li) / den;
        const float* br = a.in[10] + ((size_t)(l * 32 + g) * 64 + n) * 16; const float* bi = a.in[11] + ((size_t)(l * 32 + g) * 64 + n) * 16;
        bf16* ore = (bf16*)(ws + WS_S5B) + ((size_t)(l * 32 + g) * 128 + n) * 16; bf16* oim = ore + 64 * 16;
#pragma unroll
        for (int c = 0; c < 16; ++c) { const float r_ = br[c], i_ = bi[c]; ore[c] = (bf16)f2bf(zr * r_ - zi * i_); oim[c] = (bf16)f2bf(zr * i_ + zi * r_); } }
    { const float* x = a.in[0]; bf16* xb = (bf16*)(ws + WS_XB);
      for (int row = gw; row < M; row += NGW) {
          const f32x4* xr = (const f32x4*)(x + (size_t)row * D) + lane; float s = 0.f;
          v2u* o8 = (v2u*)(xb + (size_t)row * D) + lane;
#pragma unroll
          for (int j = 0; j < 8; ++j) { const f32x4 v = xr[64 * j]; s += (v[0] * v[0] + v[1] * v[1]) + (v[2] * v[2] + v[3] * v[3]); v2u w; w.x = pk2(v[0], v[1]); w.y = pk2(v[2], v[3]); o8[64 * j] = w; }
          s = wave_sum(s); if (lane == 0) ssq[row] = s; } }
}
constexpr int I_IN = 32 * 200, I_BR = 8 * 32, I_OUT = 32 * 32, I_GU = 32 * 176, I_DN = 88 * 32, I_GLU = 8 * 8;
constexpr int I_LAYER = I_IN + 4 * I_BR + I_OUT + I_GU + I_DN + I_GLU;
__device__ __forceinline__ void weight_jobs(const Args& a, unsigned char* lds, int l, int lo, int hi, int worker, int nworkers, int lane, int wave) {
    unsigned char* ws = a.ws;
    float* scr = (float*)(lds + wave * 16640);
    unsigned char* wt = ws + WS_WT + (size_t)l * WT_LAYER;
    for (int it = lo + worker; it < hi; it += nworkers) {
        int r = it;
        if (r < I_IN) { const float* w = a.in[3] + (size_t)l * D * DIN;
            transpose_item<1>(w, nullptr, DIN, a.in[2] + l * D, (bf16*)(wt + WT_IN), D, 0, 200, scr, r, lane); continue; }
        r -= I_IN;
        if (r < 4 * I_BR) { const int m = r / I_BR; const float* w = a.in[18] + ((size_t)l * 4 + m) * 512 * D;
            transpose_item<0>(w, nullptr, D, nullptr, (bf16*)(wt + WT_BR), D, m * 512, 32, scr, r % I_BR, lane); continue; }
        r -= 4 * I_BR;
        if (r < I_OUT) { const float* w = a.in[19] + (size_t)l * D * D;
            transpose_item<0>(w, nullptr, D, nullptr, (bf16*)(wt + WT_OUT), D, 0, 32, scr, r, lane); continue; }
        r -= I_OUT;
        if (r < I_GU) { const float* wg = a.in[21] + (size_t)l * D * FF; const float* wu = a.in[22] + (size_t)l * D * FF;
            transpose_item<2>(wg, wu, FF, a.in[20] + l * D, (bf16*)(wt + WT_GU), D, 0, 176, scr, r, lane); continue; }
        r -= I_GU;
        if (r < I_DN) { const float* w = a.in[23] + (size_t)l * FF * D;
            transpose_item<0>(w, nullptr, D, nullptr, (bf16*)(wt + WT_DN), FF, 0, 32, scr, r, lane); continue; }
        r -= I_DN;
        { const float* w = a.in[15] + (size_t)l * 512 * 512;
            transpose_item<0>(w, nullptr, 512, nullptr, (bf16*)(ws + WS_GLU) + (size_t)l * 512 * 512, 512, 0, 8, scr, r, lane); }
    }
}

constexpr int ATT_BUF = 70656;
struct AttnUnit { int cfg, b, h, dil, r, nb; };
__device__ __forceinline__ AttnUnit attn_decode(int unit) {
    AttnUnit A; A.cfg = unit >> 9; int rem = unit & 511; A.b = rem >> 8; rem &= 255; A.h = rem >> 5; const int blk = rem & 31;
    A.dil = A.cfg == 1 ? 4 : A.cfg == 2 ? 16 : 1; const int nbr = 32 / A.dil; A.r = blk / nbr; A.nb = blk % nbr; return A;
}
struct AttnRegs { v4u k[4], v[4]; bf16x8 q0, q1; };
__device__ __forceinline__ void attn_issue(const Args& a, int unit, AttnRegs& R, int tid, int lane, int wave) {
    const AttnUnit A = attn_decode(unit);
    const bf16* abf = (const bf16*)(a.ws + WS_ABF);
    const int qoff = A.cfg < 3 ? A.h * 64 : 1536 + A.h * 64;
    const int koff = A.cfg < 3 ? 512 + A.h * 64 : 2048 + (A.h >> 2) * 64;
    const int voff = A.cfg < 3 ? 1024 + A.h * 64 : 2176 + (A.h >> 2) * 64;
    const int kj = tid >> 1, half = tid & 1; const int si = A.nb * 128 - 128 + kj;
    if (si >= 0) {
        const size_t tok = (size_t)(A.b * SEQ + si * A.dil + A.r);
        const v4u* kp = (const v4u*)(abf + tok * 2304 + koff + half * 32); const v4u* vp = (const v4u*)(abf + tok * 2304 + voff + half * 32);
#pragma unroll
        for (int i = 0; i < 4; ++i) { R.k[i] = kp[i]; R.v[i] = vp[i]; }
    } else {
#pragma unroll
        for (int i = 0; i < 4; ++i) { R.k[i] = (v4u){0u, 0u, 0u, 0u}; R.v[i] = (v4u){0u, 0u, 0u, 0u}; }
    }
    const int fr = lane & 15, fq = lane >> 4;
    const size_t tokq = (size_t)(A.b * SEQ + (A.nb * 128 + 16 * wave + fr) * A.dil + A.r);
    const bf16* qp = abf + tokq * 2304 + qoff + 8 * fq;
    R.q0 = *(const bf16x8*)qp; R.q1 = *(const bf16x8*)(qp + 32);
}
__device__ __forceinline__ void attn_store(const AttnRegs& R, unsigned char* buf, int tid) {
    bf16* Ks = (bf16*)buf; bf16* Vt = Ks + 256 * 72;
    const int kj = tid >> 1, half = tid & 1;
    v4u* kd = (v4u*)(Ks + kj * 72 + half * 32);
#pragma unroll
    for (int i = 0; i < 4; ++i) kd[i] = R.k[i];
#pragma unroll
    for (int i = 0; i < 4; ++i) {
        const unsigned w[4] = {R.v[i].x, R.v[i].y, R.v[i].z, R.v[i].w};
#pragma unroll
        for (int j = 0; j < 4; ++j) { Vt[(half * 32 + 8 * i + 2 * j) * 264 + kj] = (bf16)(w[j] & 0xffffu); Vt[(half * 32 + 8 * i + 2 * j + 1) * 264 + kj] = (bf16)(w[j] >> 16); }
    }
}
__device__ __forceinline__ void attn_compute(const Args& a, int layer, int unit, const unsigned char* buf, const bf16x8 qf0, const bf16x8 qf1, int lane, int wave) {
    unsigned char* ws = a.ws;
    const AttnUnit A = attn_decode(unit);
    const int maxd = A.cfg == 3 ? 127 : 128;
    const bf16* Ks = (const bf16*)buf; const bf16* Vt = Ks + 256 * 72;
    const int fr = lane & 15, fq = lane >> 4;
    const int qi = 16 * wave + fr; const int tokq = A.b * SEQ + (A.nb * 128 + qi) * A.dil + A.r;
    const int ts = wave < 6 ? wave : 6;
    f32x4 s[10];
#pragma unroll
    for (int i = 0; i < 10; ++i) {
        const bf16* kr = Ks + ((ts + i) * 16 + fr) * 72 + 8 * fq;
        const bf16x8 k0 = *(const bf16x8*)kr, k1 = *(const bf16x8*)(kr + 32);
        f32x4 z = (f32x4){0.f, 0.f, 0.f, 0.f};
        if (!((i == 9 && wave < 7) || (i == 0 && wave == 7))) {
            z = __builtin_amdgcn_mfma_f32_16x16x32_bf16(k0, qf0, z, 0, 0, 0);
            z = __builtin_amdgcn_mfma_f32_16x16x32_bf16(k1, qf1, z, 0, 0, 0); }
        s[i] = z;
    }
    float mx = -INFINITY;
#pragma unroll
    for (int i = 0; i < 10; ++i)
#pragma unroll
        for (int j = 0; j < 4; ++j) {
            const int kj = (ts + i) * 16 + 4 * fq + j; const int dist = 128 + qi - kj;
            const bool valid = (dist >= 0) && (dist <= maxd) && (A.nb * 128 - 128 + kj >= 0);
            const float v = valid ? s[i][j] : -INFINITY; s[i][j] = v; mx = fmaxf(mx, v);
        }
    mx = fmaxf(mx, __shfl_xor(mx, 16)); mx = fmaxf(mx, __shfl_xor(mx, 32));
    float l = 0.f;
#pragma unroll
    for (int i = 0; i < 10; ++i)
#pragma unroll
        for (int j = 0; j < 4; ++j) { const float p = __expf(s[i][j] - mx); s[i][j] = p; l += p; }
    l += __shfl_xor(l, 16); l += __shfl_xor(l, 32);
    f32x4 o[4];
#pragma unroll
    for (int dt = 0; dt < 4; ++dt) o[dt] = (f32x4){0.f, 0.f, 0.f, 0.f};
#pragma unroll
    for (int p = 0; p < 5; ++p) {
        bf16x8 pf;
        { const unsigned w0 = pk2(s[2 * p][0], s[2 * p][1]), w1 = pk2(s[2 * p][2], s[2 * p][3]), w2 = pk2(s[2 * p + 1][0], s[2 * p + 1][1]), w3 = pk2(s[2 * p + 1][2], s[2 * p + 1][3]);
          pf[0] = (short)(w0 & 0xffff); pf[1] = (short)(w0 >> 16); pf[2] = (short)(w1 & 0xffff); pf[3] = (short)(w1 >> 16);
          pf[4] = (short)(w2 & 0xffff); pf[5] = (short)(w2 >> 16); pf[6] = (short)(w3 & 0xffff); pf[7] = (short)(w3 >> 16); }
#pragma unroll
        for (int dt = 0; dt < 4; ++dt) {
            const bf16* vr = Vt + (dt * 16 + fr) * 264 + (ts + 2 * p) * 16 + 4 * fq;
            const s16x4 v0 = *(const s16x4*)vr, v1 = *(const s16x4*)(vr + 16);
            bf16x8 vf; vf[0] = v0[0]; vf[1] = v0[1]; vf[2] = v0[2]; vf[3] = v0[3]; vf[4] = v1[0]; vf[5] = v1[1]; vf[6] = v1[2]; vf[7] = v1[3];
            o[dt] = __builtin_amdgcn_mfma_f32_16x16x32_bf16(vf, pf, o[dt], 0, 0, 0);
        }
    }
    if (A.cfg == 3) {
        const float lse = mx + __logf(l); const float sink = a.in[17][layer * 8 + A.h];
        const float sc = __frcp_rn(1.0f + __expf(sink - lse)) / l;
        bf16* brp = (bf16*)(ws + WS_BR) + (size_t)tokq * 2048 + 1536 + A.h * 64 + 4 * fq;
#pragma unroll
        for (int dt = 0; dt < 4; ++dt) { v2u w; w.x = pk2(o[dt][0] * sc, o[dt][1] * sc); w.y = pk2(o[dt][2] * sc, o[dt][3] * sc); __builtin_nontemporal_store(w, (v2u*)(brp + dt * 16)); }
    } else {
        bf16* op = (bf16*)(ws + WS_OPART) + ((size_t)A.cfg * M + tokq) * 512 + A.h * 64 + 4 * fq;
#pragma unroll
        for (int dt = 0; dt < 4; ++dt) { v2u w; w.x = pk2(o[dt][0], o[dt][1]); w.y = pk2(o[dt][2], o[dt][3]); __builtin_nontemporal_store(w, (v2u*)(op + dt * 16)); }
        if (fq == 0) { float* mlp = (float*)(ws + WS_ML) + (((size_t)A.cfg * M + tokq) * 8 + A.h) * 2; mlp[0] = mx; mlp[1] = l; }
    }
}
__device__ __forceinline__ void attn_phase(const Args& a, int layer, unsigned* cnt, unsigned char* lds, int tid, int lane, int wave) {
    volatile int* su = (volatile int*)(lds + 143360);
    if (tid == 0) { su[0] = (int)atomicAdd(cnt, 1u); su[1] = (int)atomicAdd(cnt, 1u); }
    __syncthreads();
    int ucur = su[0], unxt = su[1];
    if (ucur >= 2048) return;
    AttnRegs R; bf16x8 qc0, qc1;
    attn_issue(a, ucur, R, tid, lane, wave); attn_store(R, lds, tid); qc0 = R.q0; qc1 = R.q1;
    __syncthreads();
    int p = 0;
    for (;;) {
        if (tid == 0) su[p] = (int)atomicAdd(cnt, 1u);
        const bool hn = unxt < 2048;
        if (hn) attn_issue(a, unxt, R, tid, lane, wave);
        attn_compute(a, layer, ucur, lds + p * ATT_BUF, qc0, qc1, lane, wave);
        if (hn) { attn_store(R, lds + (p ^ 1) * ATT_BUF, tid); qc0 = R.q0; qc1 = R.q1; }
        __syncthreads();
        ucur = unxt; unxt = su[p]; p ^= 1;
        if (ucur >= 2048) break;
    }
}

__device__ __forceinline__ void dil_merge(const Args& a, int gtid, int NGT) {
    unsigned char* ws = a.ws;
    const bf16* opart = (const bf16*)(ws + WS_OPART); const float* ml = (const float*)(ws + WS_ML);
    bf16* br = (bf16*)(ws + WS_BR);
    for (int it = gtid; it < M * 64; it += NGT) {
        const int tok = it >> 6, c8 = it & 63, h = c8 >> 3;
        float m[3], l[3];
#pragma unroll
        for (int c = 0; c < 3; ++c) { const float* p = ml + (((size_t)c * M + tok) * 8 + h) * 2; m[c] = p[0]; l[c] = p[1]; }
        const float mm = fmaxf(m[0], fmaxf(m[1], m[2]));
        float w[3], den = 0.f;
#pragma unroll
        for (int c = 0; c < 3; ++c) { w[c] = __expf(m[c] - mm); den += w[c] * l[c]; }
        const float inv = 1.0f / den;
        float acc[8];
#pragma unroll
        for (int i = 0; i < 8; ++i) acc[i] = 0.f;
#pragma unroll
        for (int c = 0; c < 3; ++c) { const v4u x = *(const v4u*)(opart + ((size_t)c * M + tok) * 512 + c8 * 8);
            acc[0] += w[c] * __uint_as_float(x.x << 16); acc[1] += w[c] * __uint_as_float(x.x & 0xffff0000u); acc[2] += w[c] * __uint_as_float(x.y << 16); acc[3] += w[c] * __uint_as_float(x.y & 0xffff0000u);
            acc[4] += w[c] * __uint_as_float(x.z << 16); acc[5] += w[c] * __uint_as_float(x.z & 0xffff0000u); acc[6] += w[c] * __uint_as_float(x.w << 16); acc[7] += w[c] * __uint_as_float(x.w & 0xffff0000u); }
        v4u o; o.x = pk2(acc[0] * inv, acc[1] * inv); o.y = pk2(acc[2] * inv, acc[3] * inv); o.z = pk2(acc[4] * inv, acc[5] * inv); o.w = pk2(acc[6] * inv, acc[7] * inv);
        *(v4u*)(br + (size_t)tok * 2048 + 1024 + c8 * 8) = o;
    }
}

__device__ __forceinline__ v4u pack8(const float (&x)[8]) { v4u w; w.x = pk2(x[0], x[1]); w.y = pk2(x[2], x[3]); w.z = pk2(x[4], x[5]); w.w = pk2(x[6], x[7]); return w; }
__device__ __forceinline__ void gla_g1(const Args& a, int layer, int unit, unsigned char* lds, int tid, int lane, int wave) {
    const int bh = unit >> 6, n = unit & 63, b = bh >> 2, h = bh & 3;
    bf16* keT = (bf16*)lds;
    bf16* vT = keT + 64 * 72;
    float* tot = (float*)(lds + 32768);
    float* lastb = tot + 512;
    float* cumL = (float*)(lds + 36864);
    const float* projm = (const float*)(a.ws + WS_PROJM);
    float* gcum = (float*)(a.ws + WS_GCUM);
    const int t_ = tid >> 3, c8 = tid & 7; const size_t tok_ = (size_t)(b * SEQ + n * 64 + t_);
    const f32x4 kr0 = *(const f32x4*)(projm + tok_ * NMIX + C_GK + h * 64 + 8 * c8), kr1 = *(const f32x4*)(projm + tok_ * NMIX + C_GK + h * 64 + 8 * c8 + 4);
    f32x4 vr[4];
#pragma unroll
    for (int i = 0; i < 4; ++i) vr[i] = *(const f32x4*)(projm + tok_ * NMIX + C_GV + h * 128 + 16 * c8 + 4 * i);
    {
        const float* a2 = a.in[4] + (size_t)layer * 16 * 256; const float* ab = a.in[5] + layer * 256;
        const int k = tid & 63, tg = tid >> 6;
        float w[16];
#pragma unroll
        for (int r = 0; r < 16; ++r) w[r] = a2[r * 256 + h * 64 + k];
        const float bias = ab[h * 64 + k];
        float p[8]; float run = 0.f;
#pragma unroll
        for (int i = 0; i < 8; ++i) {
            const size_t tok = (size_t)(b * SEQ + n * 64 + tg * 8 + i);
            const f32x4* gp = (const f32x4*)(projm + tok * NMIX + C_LR);
            float z = bias;
#pragma unroll
            for (int q = 0; q < 4; ++q) { const f32x4 g4 = gp[q]; z += g4[0] * w[4 * q] + g4[1] * w[4 * q + 1] + g4[2] * w[4 * q + 2] + g4[3] * w[4 * q + 3]; }
            const float ls = fminf(z, 0.f) - __logf(1.0f + __expf(-fabsf(z)));
            run += ls * (1.0f / 16.0f); p[i] = run;
        }
        tot[tg * 64 + k] = run;
        __syncthreads();
        float off = 0.f;
#pragma unroll
        for (int g = 0; g < 7; ++g) off += (g < tg) ? tot[g * 64 + k] : 0.f;
#pragma unroll
        for (int i = 0; i < 8; ++i) { const float c = off + p[i]; const int t = tg * 8 + i; cumL[t * 65 + k] = c; gcum[(size_t)(b * SEQ + n * 64 + t) * 256 + h * 64 + k] = c; }
        if (tg == 7) { lastb[k] = off + p[7]; ((float*)(a.ws + WS_GLAST))[unit * 64 + k] = off + p[7]; }
    }
    __syncthreads();
    {
        const float kx[8] = {kr0[0], kr0[1], kr0[2], kr0[3], kr1[0], kr1[1], kr1[2], kr1[3]};
#pragma unroll
        for (int j = 0; j < 8; ++j) { const int kk = 8 * c8 + j; keT[kk * 72 + t_] = (bf16)f2bf(kx[j] * __expf(lastb[kk] - cumL[t_ * 65 + kk])); }
#pragma unroll
        for (int i = 0; i < 4; ++i)
#pragma unroll
            for (int j = 0; j < 4; ++j) vT[(16 * c8 + 4 * i + j) * 72 + t_] = (bf16)f2bf(vr[i][j]);
    }
    __syncthreads();
    {
        const int fr = lane & 15, fq = lane >> 4;
        f32x4 acc[4];
#pragma unroll
        for (int kt = 0; kt < 4; ++kt) acc[kt] = (f32x4){0.f, 0.f, 0.f, 0.f};
#pragma unroll
        for (int ts = 0; ts < 2; ++ts) {
            const bf16x8 bfv = *(const bf16x8*)(vT + (wave * 16 + fr) * 72 + 32 * ts + 8 * fq);
#pragma unroll
            for (int kt = 0; kt < 4; ++kt) { const bf16x8 af = *(const bf16x8*)(keT + (kt * 16 + fr) * 72 + 32 * ts + 8 * fq); acc[kt] = __builtin_amdgcn_mfma_f32_16x16x32_bf16(af, bfv, acc[kt], 0, 0, 0); }
        }
        float* kvo = (float*)(a.ws + WS_GKV) + (size_t)unit * 64 * 128 + wave * 16 + fr;
#pragma unroll
        for (int kt = 0; kt < 4; ++kt)
#pragma unroll
            for (int j = 0; j < 4; ++j) kvo[(kt * 16 + 4 * fq + j) * 128] = acc[kt][j];
    }
    __syncthreads();
}
__device__ __forceinline__ void gla_g2(const Args& a, int idx) {
    const int bh = idx >> 13, k = (idx >> 7) & 63, v = idx & 127;
    const float* kv = (const float*)(a.ws + WS_GKV); const float* last = (const float*)(a.ws + WS_GLAST); float* st = (float*)(a.ws + WS_GST);
    float S = 0.f;
    for (int n0 = 0; n0 < 64; n0 += 16) {
        float kvv[16], dd[16];
#pragma unroll
        for (int i = 0; i < 16; ++i) { const int u = bh * 64 + n0 + i; kvv[i] = kv[((size_t)u * 64 + k) * 128 + v]; dd[i] = last[u * 64 + k]; }
#pragma unroll
        for (int i = 0; i < 16; ++i) { const int u = bh * 64 + n0 + i; st[((size_t)u * 64 + k) * 128 + v] = S; S = S * __expf(dd[i]) + kvv[i]; }
    }
}
constexpr int G3_BUF = 55296;
struct G3Regs { f32x4 c0, c1, r0, r1, q0, q1, k0, k1, v[4], s[4]; float rk; };
__device__ __forceinline__ void g3_issue(const Args& a, int unit, G3Regs& R, int tid) {
    const int bh = unit >> 6, n = unit & 63, b = bh >> 2, h = bh & 3;
    const float* projm = (const float*)(a.ws + WS_PROJM); const float* gcum = (const float*)(a.ws + WS_GCUM);
    const int t_ = tid >> 3, c8 = tid & 7; const size_t tok_ = (size_t)(b * SEQ + n * 64 + t_), tok31 = (size_t)(b * SEQ + n * 64 + 31);
    R.c0 = *(const f32x4*)(gcum + tok_ * 256 + h * 64 + 8 * c8); R.c1 = *(const f32x4*)(gcum + tok_ * 256 + h * 64 + 8 * c8 + 4);
    R.r0 = *(const f32x4*)(gcum + tok31 * 256 + h * 64 + 8 * c8); R.r1 = *(const f32x4*)(gcum + tok31 * 256 + h * 64 + 8 * c8 + 4);
    R.rk = gcum[tok31 * 256 + h * 64 + t_];
    R.q0 = *(const f32x4*)(projm + tok_ * NMIX + C_GQ + h * 64 + 8 * c8); R.q1 = *(const f32x4*)(projm + tok_ * NMIX + C_GQ + h * 64 + 8 * c8 + 4);
    R.k0 = *(const f32x4*)(projm + tok_ * NMIX + C_GK + h * 64 + 8 * c8); R.k1 = *(const f32x4*)(projm + tok_ * NMIX + C_GK + h * 64 + 8 * c8 + 4);
    const float* stp = (const float*)(a.ws + WS_GST) + (size_t)unit * 64 * 128 + t_ * 128 + 16 * c8;
#pragma unroll
    for (int i = 0; i < 4; ++i) { R.v[i] = *(const f32x4*)(projm + tok_ * NMIX + C_GV + h * 128 + 16 * c8 + 4 * i); R.s[i] = *(const f32x4*)(stp + 4 * i); }
}
__device__ __forceinline__ void g3_stage(const G3Regs& R, unsigned char* buf, int tid) {
    bf16* qeL = (bf16*)buf; bf16* keL = qeL + 64 * 72; bf16* vT = keL + 64 * 72; bf16* SsT = vT + 128 * 72;
    const int t_ = tid >> 3, c8 = tid & 7;
    const float cc[8] = {R.c0[0], R.c0[1], R.c0[2], R.c0[3], R.c1[0], R.c1[1], R.c1[2], R.c1[3]};
    const float rr[8] = {R.r0[0], R.r0[1], R.r0[2], R.r0[3], R.r1[0], R.r1[1], R.r1[2], R.r1[3]};
    const float qq[8] = {R.q0[0], R.q0[1], R.q0[2], R.q0[3], R.q1[0], R.q1[1], R.q1[2], R.q1[3]};
    const float kk[8] = {R.k0[0], R.k0[1], R.k0[2], R.k0[3], R.k1[0], R.k1[1], R.k1[2], R.k1[3]};
    float qe[8], ke[8];
#pragma unroll
    for (int j = 0; j < 8; ++j) { const float d = cc[j] - rr[j]; qe[j] = qq[j] * 0.125f * __expf(d); ke[j] = kk[j] * __expf(-d); }
    *(v4u*)(qeL + t_ * 72 + 8 * c8) = pack8(qe); *(v4u*)(keL + t_ * 72 + 8 * c8) = pack8(ke);
    const float sc = __expf(R.rk);
#pragma unroll
    for (int i = 0; i < 4; ++i)
#pragma unroll
        for (int j = 0; j < 4; ++j) { vT[(16 * c8 + 4 * i + j) * 72 + t_] = (bf16)f2bf(R.v[i][j]); SsT[(16 * c8 + 4 * i + j) * 72 + t_] = (bf16)f2bf(R.s[i][j] * sc); }
}
__device__ __forceinline__ void g3_compute(const Args& a, int layer, int unit, const unsigned char* buf, float* ssb, int lane, int wave) {
    const int bh = unit >> 6, n = unit & 63, b = bh >> 2, h = bh & 3;
    const bf16* qeL = (const bf16*)buf; const bf16* keL = qeL + 64 * 72; const bf16* vT = keL + 64 * 72; const bf16* SsT = vT + 128 * 72;
    const int fr = lane & 15, fq = lane >> 4, tt = wave & 3, vh = wave >> 2;
    bf16x8 qf[2];
#pragma unroll
    for (int ks = 0; ks < 2; ++ks) qf[ks] = *(const bf16x8*)(qeL + (tt * 16 + fr) * 72 + 32 * ks + 8 * fq);
    f32x4 sT[4];
#pragma unroll
    for (int jt = 0; jt < 4; ++jt) {
        f32x4 z = (f32x4){0.f, 0.f, 0.f, 0.f};
        if (jt <= tt) {
#pragma unroll
            for (int ks = 0; ks < 2; ++ks) { const bf16x8 kf = *(const bf16x8*)(keL + (jt * 16 + fr) * 72 + 32 * ks + 8 * fq); z = __builtin_amdgcn_mfma_f32_16x16x32_bf16(kf, qf[ks], z, 0, 0, 0); }
#pragma unroll
            for (int jj = 0; jj < 4; ++jj) if (jt * 16 + 4 * fq + jj > tt * 16 + fr) z[jj] = 0.f;
        }
        sT[jt] = z;
    }
    f32x4 o[4];
#pragma unroll
    for (int vt = 0; vt < 4; ++vt) o[vt] = (f32x4){0.f, 0.f, 0.f, 0.f};
#pragma unroll
    for (int p = 0; p < 2; ++p) {
        bf16x8 pf;
        { const unsigned w0 = pk2(sT[2 * p][0], sT[2 * p][1]), w1 = pk2(sT[2 * p][2], sT[2 * p][3]), w2 = pk2(sT[2 * p + 1][0], sT[2 * p + 1][1]), w3 = pk2(sT[2 * p + 1][2], sT[2 * p + 1][3]);
          pf[0] = (short)(w0 & 0xffff); pf[1] = (short)(w0 >> 16); pf[2] = (short)(w1 & 0xffff); pf[3] = (short)(w1 >> 16);
          pf[4] = (short)(w2 & 0xffff); pf[5] = (short)(w2 >> 16); pf[6] = (short)(w3 & 0xffff); pf[7] = (short)(w3 >> 16); }
#pragma unroll
        for (int vt = 0; vt < 4; ++vt) {
            const bf16* vr = vT + ((4 * vh + vt) * 16 + fr) * 72 + 32 * p + 4 * fq;
            const s16x4 v0 = *(const s16x4*)vr, v1 = *(const s16x4*)(vr + 16);
            bf16x8 vf; vf[0] = v0[0]; vf[1] = v0[1]; vf[2] = v0[2]; vf[3] = v0[3]; vf[4] = v1[0]; vf[5] = v1[1]; vf[6] = v1[2]; vf[7] = v1[3];
            o[vt] = __builtin_amdgcn_mfma_f32_16x16x32_bf16(vf, pf, o[vt], 0, 0, 0);
        }
    }
#pragma unroll
    for (int ks = 0; ks < 2; ++ks)
#pragma unroll
        for (int vt = 0; vt < 4; ++vt) { const bf16x8 sf = *(const bf16x8*)(SsT + ((4 * vh + vt) * 16 + fr) * 72 + 32 * ks + 8 * fq); o[vt] = __builtin_amdgcn_mfma_f32_16x16x32_bf16(sf, qf[ks], o[vt], 0, 0, 0); }
    float ss = 0.f;
#pragma unroll
    for (int vt = 0; vt < 4; ++vt) ss += (o[vt][0] * o[vt][0] + o[vt][1] * o[vt][1]) + (o[vt][2] * o[vt][2] + o[vt][3] * o[vt][3]);
    ss += __shfl_xor(ss, 16); ss += __shfl_xor(ss, 32);
    if (fq == 0) ssb[vh * 64 + tt * 16 + fr] = ss;
    __syncthreads();
    const float rstd = rsqrtf((ssb[tt * 16 + fr] + ssb[64 + tt * 16 + fr]) * (1.0f / 128.0f) + 1e-6f);
    const size_t tok = (size_t)(b * SEQ + n * 64 + tt * 16 + fr);
    const float* projm = (const float*)(a.ws + WS_PROJM);
#pragma unroll
    for (int vt = 0; vt < 4; ++vt) { const int v0 = (4 * vh + vt) * 16 + 4 * fq;
        const f32x4 gn = *(const f32x4*)(a.in[6] + (size_t)layer * 512 + h * 128 + v0); const f32x4 gr = *(const f32x4*)(projm + tok * NMIX + C_GR + h * 128 + v0);
        float ov[4];
#pragma unroll
        for (int jj = 0; jj < 4; ++jj) { const float g = gr[jj]; ov[jj] = o[vt][jj] * rstd * gn[jj] * (g * __frcp_rn(1.0f + __expf(-g))); }
        v2u w; w.x = pk2(ov[0], ov[1]); w.y = pk2(ov[2], ov[3]);
        *(v2u*)((bf16*)(a.ws + WS_BR) + tok * 2048 + h * 128 + v0) = w; }
}
__device__ __forceinline__ void g3_phase(const Args& a, int layer, unsigned char* lds, int tid, int lane, int wave, int bid, int G) {
    float* ssb = (float*)(lds + 2 * G3_BUF);
    int u = bid; if (u >= 512) return;
    G3Regs R; g3_issue(a, u, R, tid); g3_stage(R, lds, tid);
    __syncthreads();
    int p = 0;
    for (;;) {
        const int un = u + G; const bool hn = un < 512;
        if (hn) g3_issue(a, un, R, tid);
        g3_compute(a, layer, u, lds + p * G3_BUF, ssb + p * 128, lane, wave);
        if (hn) g3_stage(R, lds + (p ^ 1) * G3_BUF, tid);
        __syncthreads();
        if (!hn) break;
        u = un; p ^= 1;
    }
}

constexpr int S5_LC = 32, S5_NC = SEQ / S5_LC;
constexpr int XP = 132;
__device__ __forceinline__ bf16x8 cvt8(const f32x4 a0, const f32x4 a1) {
    bf16x8 r; const unsigned w0 = pk2(a0[0], a0[1]), w1 = pk2(a0[2], a0[3]), w2 = pk2(a1[0], a1[1]), w3 = pk2(a1[2], a1[3]);
    r[0] = (short)(w0 & 0xffff); r[1] = (short)(w0 >> 16); r[2] = (short)(w1 & 0xffff); r[3] = (short)(w1 >> 16);
    r[4] = (short)(w2 & 0xffff); r[5] = (short)(w2 >> 16); r[6] = (short)(w3 & 0xffff); r[7] = (short)(w3 >> 16); return r;
}
template <bool WITH_Y>
__device__ __forceinline__ void s5_group(const Args& a, int layer, int b, int ch, int g, float* xb_, bf16* zb, float& hr, float& hi, int lane) {
    const float* projm = (const float*)(a.ws + WS_PROJM);
    const int fr = lane & 15, fq = lane >> 4;
    const f32x4 ap = *(const f32x4*)((const float*)(a.ws + WS_S5A) + ((size_t)(layer * 32 + g) * 64 + lane) * 4);
    const float ar = ap[0], ai = ap[1];
    bf16x8 bbf[8];
    {   const bf16* bp = (const bf16*)(a.ws + WS_S5B) + ((size_t)(layer * 32 + g) * 128 + fr) * 16 + 8 * (fq & 1);
#pragma unroll
        for (int tl = 0; tl < 8; ++tl) { bf16x8 v = *(const bf16x8*)(bp + tl * 256); if (fq >= 2) v = (bf16x8){0, 0, 0, 0, 0, 0, 0, 0}; bbf[tl] = v; } }
    bf16x8 cf[4]; f32x4 dd4 = (f32x4){0.f, 0.f, 0.f, 0.f};
    if (WITH_Y) {
        const float* crp = a.in[12] + ((size_t)(layer * 32 + g) * 16 + fr) * 64; const float* cip = a.in[13] + ((size_t)(layer * 32 + g) * 16 + fr) * 64;
#pragma unroll
        for (int ks = 0; ks < 2; ++ks) { const f32x4 r0 = *(const f32x4*)(crp + 32 * ks + 8 * fq), r1 = *(const f32x4*)(crp + 32 * ks + 8 * fq + 4); cf[ks] = cvt8(r0, r1);
            const f32x4 i0 = *(const f32x4*)(cip + 32 * ks + 8 * fq), i1 = *(const f32x4*)(cip + 32 * ks + 8 * fq + 4); cf[2 + ks] = cvt8(-i0, -i1); }
        dd4 = *(const f32x4*)(a.in[14] + (size_t)(layer * 32 + g) * 16 + 4 * fq);
    }
#pragma unroll 1
    for (int hf = 0; hf < 2; ++hf) {
        const int tok = b * SEQ + ch * S5_LC + hf * 16 + fr;
        const float* up = projm + (size_t)tok * NMIX + C_S5 + g * 16;
        bf16x8 uf = (bf16x8){0, 0, 0, 0, 0, 0, 0, 0};
        if (fq < 2) uf = cvt8(*(const f32x4*)(up + 8 * fq), *(const f32x4*)(up + 8 * fq + 4));
        f32x4 u4 = (f32x4){0.f, 0.f, 0.f, 0.f};
        if (WITH_Y) u4 = *(const f32x4*)(up + 4 * fq);
#pragma unroll
        for (int tl = 0; tl < 8; ++tl) {
            const f32x4 xo = __builtin_amdgcn_mfma_f32_16x16x32_bf16(uf, bbf[tl], (f32x4){0.f, 0.f, 0.f, 0.f}, 0, 0, 0);
#pragma unroll
            for (int j = 0; j < 4; ++j) xb_[(4 * fq + j) * XP + tl * 16 + fr] = xo[j];
        }
        LDS_WAIT(); asm volatile("" ::: "memory");
#pragma unroll
        for (int t = 0; t < 16; ++t) {
            const float xr = xb_[t * XP + lane], xi = xb_[t * XP + 64 + lane];
            const float nr = ar * hr - ai * hi + xr, ni = ar * hi + ai * hr + xi; hr = nr; hi = ni;
            if (WITH_Y) { xb_[t * XP + lane] = hr; xb_[t * XP + 64 + lane] = hi; }
        }
        LDS_WAIT(); asm volatile("" ::: "memory");
        if (WITH_Y) {
            f32x4 y = (f32x4){0.f, 0.f, 0.f, 0.f};
#pragma unroll
            for (int ks = 0; ks < 4; ++ks) { const float* hp = xb_ + fr * XP + 32 * ks + 8 * fq; const bf16x8 hf8 = cvt8(*(const f32x4*)hp, *(const f32x4*)(hp + 4));
                y = __builtin_amdgcn_mfma_f32_16x16x32_bf16(cf[ks], hf8, y, 0, 0, 0); }
            LDS_WAIT(); asm volatile("" ::: "memory");
            float z[4];
#pragma unroll
            for (int j = 0; j < 4; ++j) { const float yy = y[j] + dd4[j] * u4[j];
                const float in = 0.7978845608028654f * (yy + 0.044715f * yy * yy * yy);
                const float th = 1.0f - 2.0f * __frcp_rn(__expf(2.0f * in) + 1.0f);
                z[j] = 0.5f * yy * (1.0f + th); }
            v2u w; w.x = pk2(z[0], z[1]); w.y = pk2(z[2], z[3]);
            *(v2u*)(zb + (hf * 16 + fr) * 520 + g * 16 + 4 * fq) = w;
        }
    }
}
__device__ __forceinline__ void s5_s1(const Args& a, int layer, int unit, unsigned char* lds, int tid, int lane, int wave) {
    const int ch = unit & 127, b = unit >> 7;
    float* xw = (float*)lds + wave * (16 * XP);
#pragma unroll 1
    for (int gi = 0; gi < 4; ++gi) {
        const int g = wave * 4 + gi;
        float hr = 0.f, hi = 0.f;
        s5_group<false>(a, layer, b, ch, g, xw, nullptr, hr, hi, lane);
        v2u w; w.x = __float_as_uint(hr); w.y = __float_as_uint(hi);
        *(v2u*)((float*)(a.ws + WS_S5E) + ((((size_t)b * 32 + g) * S5_NC + ch) * 64 + lane) * 2) = w;
    }
}
__device__ __forceinline__ void s5_s2(const Args& a, int layer, int idx) {
    const int n = idx & 63, g = (idx >> 6) & 31, b = idx >> 11;
    const f32x4 ap = *(const f32x4*)((const float*)(a.ws + WS_S5A) + ((size_t)(layer * 32 + g) * 64 + n) * 4);
    const float pr = ap[2], pi = ap[3];
    const float* e = (const float*)(a.ws + WS_S5E) + (((size_t)b * 32 + g) * S5_NC * 64 + n) * 2;
    float* c = (float*)(a.ws + WS_S5C) + (((size_t)b * 32 + g) * S5_NC * 64 + n) * 2;
    float hr = 0.f, hi = 0.f;
    for (int c0 = 0; c0 < S5_NC; c0 += 16) {
        float er[16], ei[16];
#pragma unroll
        for (int i = 0; i < 16; ++i) { const v2u w = *(const v2u*)(e + (size_t)(c0 + i) * 128); er[i] = __uint_as_float(w.x); ei[i] = __uint_as_float(w.y); }
#pragma unroll
        for (int i = 0; i < 16; ++i) { v2u w; w.x = __float_as_uint(hr); w.y = __float_as_uint(hi); *(v2u*)(c + (size_t)(c0 + i) * 128) = w;
            const float nr = pr * hr - pi * hi + er[i], ni = pr * hi + pi * hr + ei[i]; hr = nr; hi = ni; }
    }
}
__device__ __forceinline__ void s5_s3(const Args& a, int layer, int unit, unsigned char* lds, int tid, int lane, int wave) {
    const int ch = unit & 127, b = unit >> 7;
    float* xw = (float*)lds + wave * (16 * XP);
    bf16* zb = (bf16*)(lds + 69632);
#pragma unroll 1
    for (int gi = 0; gi < 4; ++gi) {
        const int g = wave * 4 + gi;
        const v2u cw = *(const v2u*)((const float*)(a.ws + WS_S5C) + ((((size_t)b * 32 + g) * S5_NC + ch) * 64 + lane) * 2);
        float hr = __uint_as_float(cw.x), hi = __uint_as_float(cw.y);
        s5_group<true>(a, layer, b, ch, g, xw, zb, hr, hi, lane);
    }
    __syncthreads();
    {
        const int fr = lane & 15, fq = lane >> 4;
        const bf16* Wt = (const bf16*)(a.ws + WS_GLU) + (size_t)layer * 512 * 512 + (size_t)(64 * wave + fr) * 512 + 8 * fq;
        const bf16* zr = zb + fr * 520 + 8 * fq;
        f32x4 acc[4][2];
#pragma unroll
        for (int nt = 0; nt < 4; ++nt) { acc[nt][0] = (f32x4){0.f, 0.f, 0.f, 0.f}; acc[nt][1] = (f32x4){0.f, 0.f, 0.f, 0.f}; }
#pragma unroll 4
        for (int ks = 0; ks < 16; ++ks) {
            bf16x8 af[4], bfr[2];
#pragma unroll
            for (int nt = 0; nt < 4; ++nt) af[nt] = *(const bf16x8*)(Wt + (size_t)nt * 16 * 512 + ks * 32);
#pragma unroll
            for (int tt = 0; tt < 2; ++tt) bfr[tt] = *(const bf16x8*)(zr + tt * 16 * 520 + ks * 32);
#pragma unroll
            for (int nt = 0; nt < 4; ++nt)
#pragma unroll
                for (int tt = 0; tt < 2; ++tt) acc[nt][tt] = __builtin_amdgcn_mfma_f32_16x16x32_bf16(af[nt], bfr[tt], acc[nt][tt], 0, 0, 0);
        }
        const float* bias = a.in[16] + layer * 512;
#pragma unroll
        for (int nt = 0; nt < 4; ++nt) { const int n0 = 64 * wave + 16 * nt + 4 * fq; const f32x4 b4 = *(const f32x4*)(bias + n0);
#pragma unroll
            for (int tt = 0; tt < 2; ++tt) { const int t = tt * 16 + fr; const v2u zz = *(const v2u*)(zb + t * 520 + n0);
                const float z0 = __uint_as_float(zz.x << 16), z1 = __uint_as_float(zz.x & 0xffff0000u), z2 = __uint_as_float(zz.y << 16), z3 = __uint_as_float(zz.y & 0xffff0000u);
                const f32x4 p = acc[nt][tt] + b4;
                v2u o; o.x = pk2(z0 * __frcp_rn(1.0f + __expf(-p[0])), z1 * __frcp_rn(1.0f + __expf(-p[1]))); o.y = pk2(z2 * __frcp_rn(1.0f + __expf(-p[2])), z3 * __frcp_rn(1.0f + __expf(-p[3])));
                *(v2u*)((bf16*)(a.ws + WS_BR) + (size_t)(b * SEQ + ch * S5_LC + t) * 2048 + 512 + n0) = o; } }
    }
    __syncthreads();
}

#define LAS __attribute__((address_space(3)))
#define XB_TMO      128
#define XB_XCNT(j)  (256  + 64 * (j))
#define XB_XSUB(j)  (1280 + 64 * (j))
#define XB_XGEN(j)  (2304 + 64 * (j))
#define XB_TOP      3328
#define XB_TOPGEN   3392
#define XB_SPIN_CAP (1u << 22)
__device__ __forceinline__ unsigned xb_ld(unsigned* p)              { return __hip_atomic_load(p, __ATOMIC_RELAXED, __HIP_MEMORY_SCOPE_AGENT); }
__device__ __forceinline__ unsigned xb_add(unsigned* p, unsigned v) { return __hip_atomic_fetch_add(p, v, __ATOMIC_RELAXED, __HIP_MEMORY_SCOPE_AGENT); }
__device__ __forceinline__ unsigned xb_xcc_id() { return (unsigned)__builtin_amdgcn_s_getreg((3 << 11) | 20) & 0xFu; }
#define XB_SPIN(cond, bar) do { unsigned _sp = 0; while (cond) { __builtin_amdgcn_s_sleep(1); \
    if ((++_sp & 255u) == 0u) { if (xb_ld(&(bar)[XB_TMO])) break; if (_sp > XB_SPIN_CAP) { atomicAdd(&(bar)[XB_TMO], 1u); break; } } } } while (0)
struct XcdBarrier { unsigned* bar; unsigned x; volatile LAS unsigned* st; };
__device__ __forceinline__ XcdBarrier xcd_barrier_post(unsigned* bar, volatile LAS unsigned* st) {
    XcdBarrier b; b.bar = bar; b.x = xb_xcc_id(); b.st = st;
    if (threadIdx.x == 0) (void)xb_add(&bar[XB_XCNT(b.x)], 1u);
    return b;
}
__device__ __forceinline__ void xcd_barrier_complete(unsigned* bar, unsigned x, unsigned& nloc, unsigned& nx) {
    const unsigned G = gridDim.x * gridDim.y * gridDim.z;
    unsigned sum, cnt, mine, sp = 0u;
    for (;;) {
        sum = 0u; cnt = 0u; mine = 0u;
#pragma unroll
        for (unsigned j = 0; j < 16; ++j) { const unsigned c = xb_ld(&bar[XB_XCNT(j)]); sum += c; cnt += (c > 0u) ? 1u : 0u; mine = (j == x) ? c : mine; }
        if (sum == G) break;
        __builtin_amdgcn_s_sleep(1);
        if ((++sp & 255u) == 0u) { if (xb_ld(&bar[XB_TMO])) break; if (sp > XB_SPIN_CAP) { atomicAdd(&bar[XB_TMO], 1u); break; } }
    }
    nloc = mine > 0u ? mine : 1u; nx = cnt > 0u ? cnt : 1u;
}
__device__ __forceinline__ void xcd_barrier(const XcdBarrier& b) {
    asm volatile("s_waitcnt vmcnt(0)" ::: "memory");
    __syncthreads();
    if (threadIdx.x == 0) {
        unsigned* bar = b.bar;
        __builtin_amdgcn_s_waitcnt(0);
        unsigned nloc = b.st[0], nx = b.st[1];
        if (nloc == 0u) { xcd_barrier_complete(bar, b.x, nloc, nx); b.st[0] = nloc; b.st[1] = nx; }
        const unsigned old = xb_add(&bar[XB_XSUB(b.x)], 1u);
        const unsigned gen = old / nloc;
        if (old + 1u == (gen + 1u) * nloc) {
            __builtin_amdgcn_fence(__ATOMIC_RELEASE, "agent");
            asm volatile("s_waitcnt vmcnt(0)" ::: "memory");
            const unsigned og = xb_add(&bar[XB_TOP], 1u);
            const unsigned tg = og / nx;
            if (og + 1u == (tg + 1u) * nx) xb_add(&bar[XB_TOPGEN], 1u);
            else XB_SPIN(xb_ld(&bar[XB_TOPGEN]) == tg, bar);
            __builtin_amdgcn_fence(__ATOMIC_ACQUIRE, "agent");
            xb_add(&bar[XB_XGEN(b.x)], 1u);
            asm volatile("s_waitcnt vmcnt(0)" ::: "memory");
        } else {
            XB_SPIN(xb_ld(&bar[XB_XGEN(b.x)]) == gen, bar);
            __builtin_amdgcn_fence(__ATOMIC_ACQUIRE, "agent");
            asm volatile("s_waitcnt vmcnt(0)" ::: "memory");
        }
    }
    __syncthreads();
}

#define PHASE_VARS const int tid = launder_v((int)threadIdx.x), lane = tid & 63, wave = __builtin_amdgcn_readfirstlane(tid >> 6); (void)lane; (void)wave; \
    Args a = a_; a.ws = launder_p(a_.ws); a.out = launder_p(a_.out); unsigned char* ws = a.ws; (void)ws; \
    const int G = gridDim.x, bid = blockIdx.x; const int gtid = bid * NTHR + tid, NGT = G * NTHR; (void)gtid; (void)NGT; \
    float* ssq = (float*)(ws + WS_SSQ); bf16* xb = (bf16*)(ws + WS_XB); (void)ssq; (void)xb; \
    unsigned char* wt = ws + WS_WT + (size_t)layer * WT_LAYER; (void)wt;
__global__ void __launch_bounds__(NTHR, 2) hybrid_fwd(Args a_) {
    extern __shared__ __attribute__((aligned(16))) unsigned char lds[];
    cg::grid_group grid = cg::this_grid();
    PG8_LAS unsigned char* ldsl = (PG8_LAS unsigned char*)lds;
#ifndef NO_PRO
    for (int rep = 0; rep < REP_PRO; ++rep) { const int layer = 0; PHASE_VARS; prologue(a, lds, tid, lane, wave, G); weight_jobs(a, lds, 0, 0, I_IN, bid * NWAVES + wave, G * NWAVES, lane, wave); __syncthreads(); }
#endif
    if (threadIdx.x < 2) ((volatile LAS unsigned*)(ldsl + 143376))[threadIdx.x] = 0u;
    grid.sync();
    const XcdBarrier xbar = xcd_barrier_post((unsigned*)(a_.ws + WS_BAR), (volatile LAS unsigned*)(ldsl + 143376));
#pragma unroll 1
    for (int layer = 0; layer < 2; ++layer) {
#ifndef NO_G1
        for (int rep = 0; rep < REP_G17; ++rep) {   PHASE_VARS; pg8::Gemm g{xb, (const bf16*)(wt + WT_IN), D, D, D}; pg8::StaticOrder S; S.init(M, NIN, G, bid);
            pg8::EpiInProj E{(float*)(ws + WS_PROJM), (bf16*)(ws + WS_GATES), (bf16*)(ws + WS_ABF), (const float*)(ws + WS_ROPE), ssq + (size_t)(2 * layer) * M};
            pg8::gemm_phase(ldsl, g, S, E);
            if (rep == 0) { const int nb = (M / 256) * (NIN / 256) % G; const int nidle = nb ? G - nb : G; const int me = nb ? bid - nb : bid;
                constexpr int DN0 = I_IN + 4 * I_BR + I_OUT + I_GU, DN1 = DN0 + I_DN;
                if (me >= 0) {
#pragma unroll 1
                    for (int seg = 0; seg < 2; ++seg) { const int lo = seg == 0 ? I_IN : DN1, hi = seg == 0 ? (layer == 0 ? DN1 : DN0) : I_LAYER;
                        weight_jobs(a, lds, layer, lo, hi, me * NWAVES + wave, nidle * NWAVES, lane, wave); } } }
            if (REP_G17 > 1) __syncthreads(); }
#endif
        GSYNC();
        for (int rep = 0; rep < REP_MIX; ++rep) {
        for (int r2 = 0; r2 < REP_P2; ++r2) {
#ifndef NO_GLA1
        for (int q3 = 0; q3 < REP_G1; ++q3) {   PHASE_VARS; for (int u = bid; u < 512; u += G) gla_g1(a, layer, u, lds, tid, lane, wave); }
#endif
#ifndef NO_S51
        {   PHASE_VARS; for (int u = bid; u < 256; u += G) s5_s1(a, layer, u, lds, tid, lane, wave); }
#endif
        }
        GSYNC();
#ifndef NO_SCAN
        {   PHASE_VARS; if (gtid < 65536) gla_g2(a, gtid); else if (gtid < 65536 + 4096) s5_s2(a, layer, gtid - 65536); }
#endif
#ifndef NO_ATT
        for (int r3 = 0; r3 < REP_P3; ++r3)
        {   PHASE_VARS; unsigned* cnt = (unsigned*)(ws + WS_CNT) + layer * 8 + rep * 4 + r3;
            attn_phase(a, layer, cnt, lds, tid, lane, wave); __syncthreads(); }
#endif
        GSYNC();
        for (int r4 = 0; r4 < REP_P4; ++r4) {
#ifndef NO_S53
        for (int q3 = 0; q3 < REP_S3; ++q3) {   PHASE_VARS; for (int u = bid; u < 256; u += G) s5_s3(a, layer, u, lds, tid, lane, wave); }
#endif
#ifndef NO_GLA3
        for (int q3 = 0; q3 < REP_G3; ++q3) {   PHASE_VARS; g3_phase(a, layer, lds, tid, lane, wave, bid, G); __syncthreads(); }
#endif
        {   PHASE_VARS; dil_merge(a, gtid, NGT); }
        }
        GSYNC();
        }
#ifndef NO_G5
        for (int q5 = 0; q5 < REP_G5; ++q5) {   PHASE_VARS; pg8::Gemm g{(const bf16*)(ws + WS_BR), (const bf16*)(wt + WT_BR), D, D, 512}; pg8::BranchOrder S{G, bid};
            pg8::EpiBranch E{(const bf16*)(ws + WS_GATES), (bf16*)(ws + WS_MIXB)};
            pg8::gemm_phase(ldsl, g, S, E); }
#endif
        GSYNC();
#ifndef NO_G6
        {   PHASE_VARS; pg8::Gemm g{(const bf16*)(ws + WS_MIXB), (const bf16*)(wt + WT_OUT), D, D, D}; pg8::StaticOrder S; S.init(M, D, G, bid);
            pg8::EpiResid E{layer == 0 ? a.in[0] : a.out, a.out, xb, ssq + (size_t)(2 * layer + 1) * M};
            pg8::gemm_phase(ldsl, g, S, E); }
#endif
        GSYNC();
#ifndef NO_G7
        for (int rep = 0; rep < REP_G17; ++rep) {   PHASE_VARS; pg8::Gemm g{xb, (const bf16*)(wt + WT_GU), D, D, D}; pg8::StaticOrder S; S.init(M, NGU, G, bid);
            pg8::EpiGateUp E{(bf16*)(ws + WS_HID), ssq + (size_t)(2 * layer + 1) * M};
            pg8::gemm_phase(ldsl, g, S, E);
            if (rep == 0) { const int nb = (M / 256) * (NGU / 256) % G; const int nidle = nb ? G - nb : G; const int me = nb ? bid - nb : bid;
                constexpr int DN0 = I_IN + 4 * I_BR + I_OUT + I_GU, DN1 = DN0 + I_DN;
                if (me >= 0) weight_jobs(a, lds, 1, layer == 0 ? 0 : DN0, layer == 0 ? I_IN : DN1, me * NWAVES + wave, nidle * NWAVES, lane, wave); }
            if (REP_G17 > 1) __syncthreads(); }
#endif
        GSYNC();
#ifndef NO_G8
        {   PHASE_VARS; pg8::Gemm g{(const bf16*)(ws + WS_HID), (const bf16*)(wt + WT_DN), FF, FF, FF}; pg8::StaticOrder S; S.init(M, D, G, bid);
            pg8::EpiResid E{a.out, a.out, xb, ssq + (size_t)(2 * layer + 2) * M};
            pg8::gemm_phase(ldsl, g, S, E); }
#endif
        GSYNC();
    }
    {   const int layer = 0; PHASE_VARS; const float* gF = a.in[24]; const int gw = bid * NWAVES + wave, NGW = G * NWAVES;
        for (int row = gw; row < M; row += NGW) {
            const float rstd = rsqrtf(ssq[4 * M + row] * (1.0f / 2048.0f) + 1e-6f);
            f32x4* xr = (f32x4*)(a.out + (size_t)row * D) + lane; const f32x4* gp = (const f32x4*)gF + lane;
#pragma unroll
            for (int j = 0; j < 8; ++j) { f32x4 v = xr[64 * j]; const f32x4 g4 = gp[64 * j]; v = v * rstd * g4; xr[64 * j] = v; }
        }
    }
}

extern "C" void kernel_launch(void* const* d_in, const int* in_sizes, int n_in, void* d_out, int out_size, void* d_ws, size_t ws_size, hipStream_t stream) {
    static int grid = 0;
    if (grid == 0) {
        if (n_in != 25 || out_size != M * D || ws_size < WS_END) { fprintf(stderr, "kernel_launch: unexpected shapes (n_in %d, out %d, ws %zu < %zu)\n", n_in, out_size, ws_size, (size_t)WS_END); grid = -1; return; }
        int dev = 0, cus = 0, per_cu = 0;
        (void)hipGetDevice(&dev); (void)hipDeviceGetAttribute(&cus, hipDeviceAttributeMultiprocessorCount, dev);
        if (hipFuncSetAttribute((const void*)hybrid_fwd, hipFuncAttributeMaxDynamicSharedMemorySize, LDS_BYTES) != hipSuccess) { fprintf(stderr, "kernel_launch: hipFuncSetAttribute failed\n"); grid = -1; return; }
        if (hipOccupancyMaxActiveBlocksPerMultiprocessor(&per_cu, (const void*)hybrid_fwd, NTHR, LDS_BYTES) != hipSuccess || per_cu < 1) { fprintf(stderr, "kernel_launch: occupancy query says %d\n", per_cu); per_cu = 1; }
        (void)hipGetLastError();
        grid = cus * per_cu;
    }
    if (grid < 0) return;
    Args a{};
    for (int i = 0; i < 25; ++i) a.in[i] = (const float*)d_in[i];
    a.out = (float*)d_out; a.ws = (unsigned char*)d_ws;
    void* args[] = {&a};
    hipError_t e = hipLaunchCooperativeKernel((const void*)hybrid_fwd, dim3(grid), dim3(NTHR), args, LDS_BYTES, stream);
    if (e != hipSuccess) fprintf(stderr, "cooperative launch failed: %s (grid %d)\n", hipGetErrorString(e), grid);
}
```
